# Optimizing an MI355X kernel written in HIP

```python
import math
import jax, jax.numpy as jnp
from jax import lax
import numpy as np

D_MODEL = 4096
BATCH = 4
SEQ = 4096
DEPTH = 1

D_HEAD = 128
D_ATTN = D_MODEL // 2
N_ATTN_HEADS = D_ATTN // D_HEAD
D_RNN = D_MODEL - D_ATTN
N_RNN_BLOCKS = 16
RNN_BLOCK = D_RNN // N_RNN_BLOCKS
D_MIX = D_ATTN + D_RNN
D_IN = 3 * D_ATTN + 2 * D_RNN
CONV_WIDTH = 4
RGLRU_C = 8.0
D_FF = int(math.ceil(8 * D_MODEL / (3 * 256))) * 256
PLE_DIM = 256
SB_BLOCK = 128
NORM_EPS = 1e-6

kernel_name = "hymba_style_stickbreak_rglru_layer"


def rms_norm(x, g):
    xf = x.astype(jnp.float32)
    y = xf * lax.rsqrt(jnp.mean(xf * xf, axis=-1, keepdims=True) + NORM_EPS)
    return (y * g.astype(jnp.float32)).astype(x.dtype)


def stick_breaking_attention(q, k, v):
    S = q.shape[1]
    dh = q.shape[-1]
    scale = dh ** -0.5
    outs = []
    for blk in range(S // SB_BLOCK):
        q0 = blk * SB_BLOCK
        kv_len = q0 + SB_BLOCK
        qb = q[:, q0:kv_len]
        kb = k[:, :kv_len]
        vb = v[:, :kv_len]
        z = jnp.einsum("bqhd,bkhd->bhqk", qb, kb).astype(jnp.float32) * scale
        t_idx = q0 + jnp.arange(SB_BLOCK)[:, None]
        s_idx = jnp.arange(kv_len)[None, :]
        causal = s_idx < t_idx
        log_keep = jnp.where(causal, -jax.nn.softplus(z), 0.0)
        after = lax.cumsum(log_keep, axis=3, reverse=True) - log_keep
        w = jnp.where(causal, jnp.exp(jax.nn.log_sigmoid(z) + after), 0.0)
        outs.append(jnp.einsum("bhqk,bkhd->bqhd", w.astype(vb.dtype), vb))
    return jnp.concatenate(outs, axis=1)


def causal_depthwise_conv(x, w, b):
    c = x.shape[-1]
    y = lax.conv_general_dilated(
        x, w[:, None, :].astype(x.dtype), window_strides=(1,),
        padding=[(CONV_WIDTH - 1, 0)],
        dimension_numbers=("NWC", "WIO", "NWC"),
        feature_group_count=c)
    return y + b.astype(x.dtype)


def rg_lru(x, w_a, b_a, w_x, b_x, lam):
    B, S, C = x.shape
    xb = x.reshape(B, S, N_RNN_BLOCKS, RNN_BLOCK)
    r = jax.nn.sigmoid(jnp.einsum("bsni,nij->bsnj", xb, w_a).reshape(B, S, C).astype(jnp.float32)
                       + b_a.astype(jnp.float32))
    i = jax.nn.sigmoid(jnp.einsum("bsni,nij->bsnj", xb, w_x).reshape(B, S, C).astype(jnp.float32)
                       + b_x.astype(jnp.float32))
    log_a = -RGLRU_C * r * jax.nn.softplus(-lam.astype(jnp.float32))
    a = jnp.exp(log_a)
    mult = jnp.sqrt(-jnp.expm1(2.0 * log_a))
    u = mult * (i * x.astype(jnp.float32))

    def combine(left, right):
        a1, b1 = left
        a2, b2 = right
        return a1 * a2, a2 * b1 + b2

    _, h = lax.associative_scan(combine, (a, u), axis=1)
    return h.astype(x.dtype)


def setup_inputs(seed: int = 0) -> dict:
    key = jax.random.key(seed)
    ks = jax.random.split(key, 24)
    f32 = jnp.float32

    def nrm(k, shape, fan_in):
        return jax.random.normal(k, shape, f32) * (fan_in ** -0.5)

    def gain(k, shape):
        return 1.0 + 0.02 * jax.random.normal(k, shape, f32)

    def bias(k, shape):
        return 0.02 * jax.random.normal(k, shape, f32)

    x = jax.random.normal(ks[0], (BATCH, SEQ, D_MODEL), f32)
    p = jax.random.normal(ks[1], (DEPTH, BATCH, SEQ, PLE_DIM), f32)
    a0 = jax.random.uniform(ks[9], (DEPTH, D_RNN), f32, 0.9, 0.999)
    base = a0 ** (1.0 / RGLRU_C)
    rg_lambda = jnp.log(base) - jnp.log1p(-base)
    return {
        "x": x,
        "p": p,
        "g_mix": gain(ks[2], (DEPTH, D_MODEL)),
        "w_in": nrm(ks[3], (DEPTH, D_MODEL, D_IN), D_MODEL),
        "conv_w": nrm(ks[4], (DEPTH, CONV_WIDTH, D_RNN), CONV_WIDTH),
        "conv_b": bias(ks[5], (DEPTH, D_RNN)),
        "w_rg_a": nrm(ks[6], (DEPTH, N_RNN_BLOCKS, RNN_BLOCK, RNN_BLOCK), RNN_BLOCK),
        "b_rg_a": bias(ks[7], (DEPTH, D_RNN)),
        "w_rg_x": nrm(ks[8], (DEPTH, N_RNN_BLOCKS, RNN_BLOCK, RNN_BLOCK), RNN_BLOCK),
        "b_rg_x": bias(ks[10], (DEPTH, D_RNN)),
        "rg_lambda": rg_lambda,
        "g_attn_out": gain(ks[11], (DEPTH, D_ATTN)),
        "g_rnn_out": gain(ks[12], (DEPTH, D_RNN)),
        "w_out": nrm(ks[13], (DEPTH, D_MIX, D_MODEL), D_MIX),
        "g_ffn": gain(ks[14], (DEPTH, D_MODEL)),
        "w_ffn_gate": nrm(ks[15], (DEPTH, D_MODEL, D_FF), D_MODEL),
        "w_ffn_up": nrm(ks[16], (DEPTH, D_MODEL, D_FF), D_MODEL),
        "w_ffn_down": nrm(ks[17], (DEPTH, D_FF, D_MODEL), D_FF),
        "g_ple": gain(ks[18], (DEPTH, D_MODEL)),
        "w_ple_gate": nrm(ks[19], (DEPTH, D_MODEL, D_MODEL), D_MODEL),
        "w_ple_proj": nrm(ks[20], (DEPTH, PLE_DIM, D_MODEL), PLE_DIM),
        "g_ple_out": gain(ks[21], (DEPTH, D_MODEL)),
        "g_final": gain(ks[22], (D_MODEL,)),
    }


def reference(x, p, g_mix, w_in, conv_w, conv_b, w_rg_a, b_rg_a, w_rg_x, b_rg_x,
              rg_lambda, g_attn_out, g_rnn_out, w_out, g_ffn, w_ffn_gate, w_ffn_up,
              w_ffn_down, g_ple, w_ple_gate, w_ple_proj, g_ple_out, g_final):
    B, S, _ = x.shape
    split_pts = [D_ATTN, 2 * D_ATTN, 3 * D_ATTN, 3 * D_ATTN + D_RNN]
    h = x
    for l in range(DEPTH):
        u = rms_norm(h, g_mix[l])
        proj = u @ w_in[l]
        q, k, v, xr, gr = jnp.split(proj, split_pts, axis=-1)
        q = q.reshape(B, S, N_ATTN_HEADS, D_HEAD)
        k = k.reshape(B, S, N_ATTN_HEADS, D_HEAD)
        v = v.reshape(B, S, N_ATTN_HEADS, D_HEAD)
        attn = stick_breaking_attention(q, k, v).reshape(B, S, D_ATTN)

        xr = causal_depthwise_conv(xr, conv_w[l], conv_b[l])
        rec = rg_lru(xr, w_rg_a[l], b_rg_a[l], w_rg_x[l], b_rg_x[l], rg_lambda[l])
        rec = rec * jax.nn.gelu(gr, approximate=True)

        mixed = jnp.concatenate([rms_norm(attn, g_attn_out[l]),
                                 rms_norm(rec, g_rnn_out[l])], axis=-1)
        h = h + mixed @ w_out[l]

        f = rms_norm(h, g_ffn[l])
        h = h + (jax.nn.silu(f @ w_ffn_gate[l]) * (f @ w_ffn_up[l])) @ w_ffn_down[l]

        pe = rms_norm(p[l] @ w_ple_proj[l], g_ple_out[l])
        gate = jax.nn.sigmoid(rms_norm(h, g_ple[l]) @ w_ple_gate[l])
        h = h + gate * pe
    return rms_norm(h, g_final)
```

```cpp
#include <hip/hip_runtime.h>
#include <cstdio>
#include <cstdint>

namespace pg8 {
#define PG8_LAS __attribute__((address_space(3)))
typedef unsigned short bf16_t;
typedef short bf16x8 __attribute__((ext_vector_type(8)));
typedef float f32x4 __attribute__((ext_vector_type(4)));
typedef unsigned u32x4 __attribute__((ext_vector_type(4)));
typedef unsigned u32x2 __attribute__((ext_vector_type(2)));
constexpr int BM = 256, BK = 64, HALF = 128, HTB = HALF * BK * 2  , STAGE_BYTES = 8 * HTB, NXCD = 8, WGM = 8;

__host__ __device__ __forceinline__ int lds_byte(int r, int c) { const int st = (r >> 4) * 2 + (c >> 5), rr = r & 15, cc = c & 31, ob = rr * 64 + cc * 2; return st * 1024 + (ob ^ (((ob >> 9) & 1) << 5)); }
__host__ __device__ __forceinline__ void stage_rc(int b, int& R, int& C) { const int st = b / 1024, sb = b % 1024, swz = sb ^ (((sb >> 9) & 1) << 5); R = (st >> 1) * 16 + swz / 64; C = (st & 1) * 32 + (swz % 64) / 2; }
__host__ __device__ __forceinline__ int perm32(int rho) { const int n = rho >> 4, i = rho & 15; return 8 * (i >> 2) + 4 * n + (i & 3); }

struct Unit { int pm, pn; };
struct Gemm { const bf16_t* A; const bf16_t* Bt; int M, N, K, pad; };

struct StaticOrder {
    int nM, nN, nwg, G, c;
    __host__ __device__ void init(int M, int N, int G_, int c_) { nM = M / BM; nN = N / BM; nwg = nM * nN; G = G_; c = c_; }
    __host__ __device__ bool next(int i, Unit& u) const {
        const long L = (long)i * G + c; if (L >= nwg) return false;
        int wgid = (int)L; { const int q = nwg / NXCD, r = nwg % NXCD, xcd = wgid % NXCD, off = wgid / NXCD; wgid = (xcd < r ? xcd * (q + 1) : r * (q + 1) + (xcd - r) * q) + off; }
        const int nig = WGM * nN, gid = wgid / nig, fm = gid * WGM, gsz = (nM - fm) < WGM ? (nM - fm) : WGM;
        u.pm = fm + ((wgid % nig) % gsz); u.pn = (wgid % nig) / gsz; return true;
    }
    __device__ __forceinline__ void a_ready(const Unit&) const {}
    __device__ __forceinline__ void done(const Unit&) const {}
};

__device__ __forceinline__ unsigned cvt_pk_bf16(float lo, float hi) { unsigned r; asm volatile("v_cvt_pk_bf16_f32 %0, %1, %2" : "=v"(r) : "v"(lo), "v"(hi)); return r; }

struct EpiBf16S {
    static constexpr bool PERM = true, AFTER_DRAIN = false;
    bf16_t* O; int ldc; int nscale; float sc; int pad;
    __device__ __forceinline__ void operator()(const f32x4 (&acc)[2][2][4][2], const Unit& u, int wr, int wc, int fr, int fq) const {
        const int row0 = u.pm * BM + wr * 64 + fr, col0 = u.pn * BM + wc * 32 + 8 * fq;
        const float s = (u.pn < nscale) ? sc : 1.f;
#pragma unroll
        for (int ai = 0; ai < 2; ++ai)
#pragma unroll
            for (int m = 0; m < 4; ++m) { bf16_t* rowp = O + (size_t)(row0 + ai * HALF + m * 16) * ldc + col0;
#pragma unroll
                for (int bj = 0; bj < 2; ++bj) { const f32x4 v0 = acc[ai][bj][m][0] * s, v1 = acc[ai][bj][m][1] * s;
                    u32x4 w; w.x = cvt_pk_bf16(v0[0], v0[1]); w.y = cvt_pk_bf16(v0[2], v0[3]); w.z = cvt_pk_bf16(v1[0], v1[1]); w.w = cvt_pk_bf16(v1[2], v1[3]);
                    *(u32x4*)(rowp + bj * HALF) = w; } }
    }
};
struct EpiRes {
    static constexpr bool PERM = false, AFTER_DRAIN = false;
    const float* base; float* out; int ldc; int pad;
    __device__ __forceinline__ void operator()(const f32x4 (&acc)[2][2][4][2], const Unit& u, int wr, int wc, int fr, int fq) const {
        const int row0 = u.pm * BM + wr * 64 + fr, col0 = u.pn * BM + wc * 32 + 4 * fq;
#pragma unroll
        for (int ai = 0; ai < 2; ++ai)
#pragma unroll
            for (int m = 0; m < 4; ++m) { const size_t off = (size_t)(row0 + ai * HALF + m * 16) * ldc + col0;
                f32x4 bs[2][2];
#pragma unroll
                for (int bj = 0; bj < 2; ++bj)
#pragma unroll
                    for (int n = 0; n < 2; ++n) bs[bj][n] = *(const f32x4*)(base + off + bj * HALF + n * 16);
#pragma unroll
                for (int bj = 0; bj < 2; ++bj)
#pragma unroll
                    for (int n = 0; n < 2; ++n) *(f32x4*)(out + off + bj * HALF + n * 16) = bs[bj][n] + acc[ai][bj][m][n];
                asm volatile("" ::: "memory"); }
    }
};
struct EpiSwiGLU {
    static constexpr bool PERM = true, AFTER_DRAIN = false;
    bf16_t* O; int ldc; int pad;
    __device__ __forceinline__ void operator()(const f32x4 (&acc)[2][2][4][2], const Unit& u, int wr, int wc, int fr, int fq) const {
        const int row0 = u.pm * BM + wr * 64 + fr, col0 = u.pn * HALF + wc * 32 + 8 * fq;
#pragma unroll
        for (int ai = 0; ai < 2; ++ai)
#pragma unroll
            for (int m = 0; m < 4; ++m) { bf16_t* rowp = O + (size_t)(row0 + ai * HALF + m * 16) * ldc + col0;
                float r[8];
#pragma unroll
                for (int n = 0; n < 2; ++n)
#pragma unroll
                    for (int j = 0; j < 4; ++j) { const float g = acc[ai][0][m][n][j], up = acc[ai][1][m][n][j];
                        const float e = __builtin_amdgcn_exp2f(-1.4426950408889634f * g); r[n * 4 + j] = g * __builtin_amdgcn_rcpf(1.0f + e) * up; }
                u32x4 w; w.x = cvt_pk_bf16(r[0], r[1]); w.y = cvt_pk_bf16(r[2], r[3]); w.z = cvt_pk_bf16(r[4], r[5]); w.w = cvt_pk_bf16(r[6], r[7]);
                *(u32x4*)rowp = w; }
    }
};
struct EpiPleGate {
    static constexpr bool PERM = false, AFTER_DRAIN = false;
    const float* base; float* out; const bf16_t* pe; int ldc; int pad;
    __device__ __forceinline__ void operator()(const f32x4 (&acc)[2][2][4][2], const Unit& u, int wr, int wc, int fr, int fq) const {
        const int row0 = u.pm * BM + wr * 64 + fr, col0 = u.pn * BM + wc * 32 + 4 * fq;
#pragma unroll
        for (int ai = 0; ai < 2; ++ai)
#pragma unroll
            for (int m = 0; m < 4; ++m) { const size_t off = (size_t)(row0 + ai * HALF + m * 16) * ldc + col0;
                f32x4 bs[2][2]; u32x2 pv[2][2];
#pragma unroll
                for (int bj = 0; bj < 2; ++bj)
#pragma unroll
                    for (int n = 0; n < 2; ++n) { bs[bj][n] = *(const f32x4*)(base + off + bj * HALF + n * 16); pv[bj][n] = *(const u32x2*)(pe + off + bj * HALF + n * 16); }
#pragma unroll
                for (int bj = 0; bj < 2; ++bj)
#pragma unroll
                    for (int n = 0; n < 2; ++n) { const f32x4 a = acc[ai][bj][m][n]; f32x4 o;
                        const float p0 = __uint_as_float(pv[bj][n].x << 16), p1 = __uint_as_float(pv[bj][n].x & 0xffff0000u), p2 = __uint_as_float(pv[bj][n].y << 16), p3 = __uint_as_float(pv[bj][n].y & 0xffff0000u);
                        o[0] = bs[bj][n][0] + __builtin_amdgcn_rcpf(1.0f + __builtin_amdgcn_exp2f(-1.4426950408889634f * a[0])) * p0;
                        o[1] = bs[bj][n][1] + __builtin_amdgcn_rcpf(1.0f + __builtin_amdgcn_exp2f(-1.4426950408889634f * a[1])) * p1;
                        o[2] = bs[bj][n][2] + __builtin_amdgcn_rcpf(1.0f + __builtin_amdgcn_exp2f(-1.4426950408889634f * a[2])) * p2;
                        o[3] = bs[bj][n][3] + __builtin_amdgcn_rcpf(1.0f + __builtin_amdgcn_exp2f(-1.4426950408889634f * a[3])) * p3;
                        *(f32x4*)(out + off + bj * HALF + n * 16) = o; }
                asm volatile("" ::: "memory"); }
    }
};

template <class Epi, class Sched, bool ALIGN_EPI = false, bool SP2 = false>
__device__ __forceinline__ void gemm_phase(PG8_LAS unsigned char* lds, const Gemm g, const Sched& S, const Epi& E) {
    const int tid = threadIdx.x, wid = __builtin_amdgcn_readfirstlane(tid >> 6), lane = tid & 63, wr = wid >> 2, wc = wid & 3, fr = lane & 15, fq = lane >> 4;
    const int K = g.K, nt = K / BK;
    unsigned voffA[2], voffB[2];
#pragma unroll
    for (int i = 0; i < 2; ++i) { int R, C; stage_rc(tid * 16 + i * 8192, R, C); const int Rb = Epi::PERM ? ((R & ~31) + perm32(R & 31)) : R;
        voffA[i] = (unsigned)(R * K + C) * 2u; voffB[i] = (unsigned)(Rb * K + C) * 2u; }
    const size_t kstep = (size_t)(BK * 2);
    const size_t hstep = (size_t)HALF * K * 2;
    const size_t tstep = 2 * hstep;
    const unsigned ldsw = (unsigned)wid * 1024u;
    const int aoff = lds_byte(wr * 64 + fr, fq * 8), boff = lds_byte(wc * 32 + fr, fq * 8);
#define PG8_SA(b, h) (((b) * 2 + (h)) * HTB)
#define PG8_SB(b, h) ((4 + (b) * 2 + (h)) * HTB)
#define PG8_STAGE(bufoff, gbase, voff) do { _Pragma("unroll") for (int _i = 0; _i < 2; ++_i) \
        __builtin_amdgcn_global_load_lds((const unsigned*)((const char*)(gbase) + (voff)[_i]), (PG8_LAS unsigned*)(lds + (bufoff) + ldsw + _i * 8192), 16, 0, 0); } while (0)
#define PG8_LDA(dst, b, h) do { _Pragma("unroll") for (int m = 0; m < 4; ++m) _Pragma("unroll") for (int k = 0; k < 2; ++k) dst[m][k] = *(const PG8_LAS bf16x8*)(lds + PG8_SA(b, h) + aoff + m * 2048 + k * 1024); } while (0)
#define PG8_LDB(dst, b, h) do { _Pragma("unroll") for (int n = 0; n < 2; ++n) _Pragma("unroll") for (int k = 0; k < 2; ++k) dst[n][k] = *(const PG8_LAS bf16x8*)(lds + PG8_SB(b, h) + boff + n * 2048 + k * 1024); } while (0)
#define PG8_MMA(ai, bj, At, Bt) do { __builtin_amdgcn_s_setprio(1); _Pragma("unroll") for (int m = 0; m < 4; ++m) _Pragma("unroll") for (int n = 0; n < 2; ++n) _Pragma("unroll") for (int k = 0; k < 2; ++k) \
        acc[ai][bj][m][n] = __builtin_amdgcn_mfma_f32_16x16x32_bf16(Bt[n][k], At[m][k], acc[ai][bj][m][n], 0, 0, 0); __builtin_amdgcn_s_setprio(0); } while (0)
#define PG8_WAIT_V(n) asm volatile("s_waitcnt vmcnt(" #n ")" ::: "memory")
#define PG8_WAIT_L(n) asm volatile("s_waitcnt lgkmcnt(" #n ")" ::: "memory")
#define PG8_BAR __builtin_amdgcn_s_barrier()
#define PG8_SCHED __builtin_amdgcn_sched_barrier(0)
    Unit cur, nxt; int ui = 0;
    if (!S.next(0, cur)) return;
    f32x4 acc[2][2][4][2];
#pragma unroll
    for (int a = 0; a < 2; ++a)
#pragma unroll
        for (int b = 0; b < 2; ++b)
#pragma unroll
            for (int m = 0; m < 4; ++m)
#pragma unroll
                for (int n = 0; n < 2; ++n) acc[a][b][m][n] = (f32x4){0.f, 0.f, 0.f, 0.f};
    bf16x8 At[4][2], B0[2][2], B1[2][2];
    const char* cA = (const char*)g.A + (size_t)cur.pm * tstep; const char* cB = (const char*)g.Bt + (size_t)cur.pn * tstep;
    S.a_ready(cur);
    if constexpr (SP2) {
        PG8_STAGE(PG8_SB(0, 0), cB, voffB); PG8_STAGE(PG8_SB(0, 1), cB + hstep, voffB); PG8_STAGE(PG8_SA(0, 0), cA, voffA); PG8_STAGE(PG8_SA(0, 1), cA + hstep, voffA);
        if (wr == 1) PG8_BAR;
        PG8_WAIT_V(2); PG8_BAR;
        PG8_STAGE(PG8_SB(1, 0), cB + kstep, voffB); PG8_STAGE(PG8_SA(1, 0), cA + kstep, voffA); PG8_STAGE(PG8_SB(1, 1), cB + hstep + kstep, voffB);
        PG8_WAIT_V(6); PG8_BAR;
    } else {
        PG8_STAGE(PG8_SB(0, 0), cB, voffB); PG8_STAGE(PG8_SA(0, 0), cA, voffA); PG8_STAGE(PG8_SB(0, 1), cB + hstep, voffB); PG8_STAGE(PG8_SA(0, 1), cA + hstep, voffA);
        if (wr == 1) PG8_BAR;
        PG8_WAIT_V(4); PG8_BAR;
        PG8_STAGE(PG8_SB(1, 0), cB + kstep, voffB); PG8_STAGE(PG8_SA(1, 0), cA + kstep, voffA); PG8_STAGE(PG8_SB(1, 1), cB + hstep + kstep, voffB);
        PG8_WAIT_V(6); PG8_BAR;
    }
    for (;;) {
        const bool has_next = S.next(ui + 1, nxt);
        const char* nA = has_next ? (const char*)g.A + (size_t)nxt.pm * tstep : cA; const char* nB = has_next ? (const char*)g.Bt + (size_t)nxt.pn * tstep : cB;
        for (int t = 0; t < nt; t += 2) {
            const bool last = (t == nt - 2);
            const char* a1 = cA + (size_t)(t + 1) * kstep;
            const char* a2 = last ? nA : cA + (size_t)(t + 2) * kstep; const char* b2 = last ? nB : cB + (size_t)(t + 2) * kstep;
            const char* a3 = a2 + kstep; const char* b3 = b2 + kstep;
            if (last && has_next) S.a_ready(nxt);
            if constexpr (SP2) {
            PG8_LDB(B0, 0, 0); PG8_LDB(B1, 0, 1); PG8_SCHED; PG8_LDA(At, 0, 0); PG8_STAGE(PG8_SA(1, 1), a1 + hstep, voffA);
            PG8_WAIT_V(8); PG8_WAIT_L(0); PG8_BAR; PG8_MMA(0, 0, At, B0); PG8_MMA(0, 1, At, B1); PG8_BAR; PG8_SCHED;
            PG8_LDA(At, 0, 1); PG8_STAGE(PG8_SB(0, 0), b2, voffB); PG8_STAGE(PG8_SB(0, 1), b2 + hstep, voffB); PG8_STAGE(PG8_SA(0, 0), a2, voffA);
            PG8_WAIT_V(8); PG8_WAIT_L(0); PG8_BAR; PG8_MMA(1, 0, At, B0); PG8_MMA(1, 1, At, B1); PG8_BAR; PG8_SCHED;
            PG8_LDB(B0, 1, 0); PG8_LDB(B1, 1, 1); PG8_SCHED; PG8_LDA(At, 1, 0); PG8_STAGE(PG8_SA(0, 1), a2 + hstep, voffA);
            PG8_WAIT_V(8); PG8_WAIT_L(0); PG8_BAR; PG8_MMA(0, 0, At, B0); PG8_MMA(0, 1, At, B1); PG8_BAR; PG8_SCHED;
            PG8_LDA(At, 1, 1); PG8_STAGE(PG8_SB(1, 0), b3, voffB); PG8_STAGE(PG8_SB(1, 1), b3 + hstep, voffB); PG8_STAGE(PG8_SA(1, 0), a3, voffA);
            PG8_WAIT_V(8); PG8_WAIT_L(0); PG8_BAR; PG8_MMA(1, 0, At, B0); PG8_MMA(1, 1, At, B1); PG8_BAR; PG8_SCHED;
            } else {
            PG8_LDB(B0, 0, 0); PG8_SCHED; PG8_LDA(At, 0, 0); PG8_STAGE(PG8_SA(1, 1), a1 + hstep, voffA);
            PG8_WAIT_L(8); PG8_BAR; PG8_WAIT_L(0); PG8_MMA(0, 0, At, B0); PG8_BAR; PG8_SCHED;
            PG8_LDB(B1, 0, 1); PG8_STAGE(PG8_SB(0, 0), b2, voffB);
            PG8_BAR; PG8_WAIT_L(0); PG8_MMA(0, 1, At, B1); PG8_BAR;
            PG8_LDA(At, 0, 1); PG8_STAGE(PG8_SA(0, 0), a2, voffA);
            PG8_BAR; PG8_WAIT_L(0); PG8_MMA(1, 0, At, B0); PG8_BAR; PG8_SCHED;
            PG8_STAGE(PG8_SB(0, 1), b2 + hstep, voffB);
            PG8_WAIT_V(6); PG8_BAR; PG8_MMA(1, 1, At, B1); PG8_BAR;
            PG8_LDB(B0, 1, 0); PG8_SCHED; PG8_LDA(At, 1, 0); PG8_STAGE(PG8_SA(0, 1), a2 + hstep, voffA);
            PG8_WAIT_L(8); PG8_BAR; PG8_WAIT_L(0); PG8_MMA(0, 0, At, B0); PG8_BAR; PG8_SCHED;
            PG8_LDB(B1, 1, 1); PG8_STAGE(PG8_SB(1, 0), b3, voffB);
            PG8_BAR; PG8_WAIT_L(0); PG8_MMA(0, 1, At, B1); PG8_BAR;
            PG8_LDA(At, 1, 1); PG8_STAGE(PG8_SA(1, 0), a3, voffA);
            PG8_BAR; PG8_WAIT_L(0); PG8_MMA(1, 0, At, B0); PG8_BAR; PG8_SCHED;
            PG8_STAGE(PG8_SB(1, 1), b3 + hstep, voffB);
            PG8_WAIT_V(6); PG8_BAR; PG8_MMA(1, 1, At, B1); PG8_BAR;
            }
        }
        if constexpr (ALIGN_EPI) { if (wr == 0) PG8_BAR; }
        if constexpr (!Epi::AFTER_DRAIN) { E(acc, cur, wr, wc, fr, fq); S.done(cur); }
        if (!has_next) break;
#pragma unroll
        for (int a = 0; a < 2; ++a)
#pragma unroll
            for (int b = 0; b < 2; ++b)
#pragma unroll
                for (int m = 0; m < 4; ++m)
#pragma unroll
                    for (int n = 0; n < 2; ++n) acc[a][b][m][n] = (f32x4){0.f, 0.f, 0.f, 0.f};
        cur = nxt; cA = nA; cB = nB; ++ui;
        if constexpr (ALIGN_EPI) { if (wr == 1) PG8_BAR; }
    }
    PG8_WAIT_V(0);
    if constexpr (!ALIGN_EPI) { if (wr == 0) PG8_BAR; }
    PG8_BAR;
#undef PG8_SA
#undef PG8_SB
#undef PG8_STAGE
#undef PG8_LDA
#undef PG8_LDB
#undef PG8_MMA
#undef PG8_WAIT_V
#undef PG8_WAIT_L
#undef PG8_BAR
#undef PG8_SCHED
}
}

constexpr int NB = 4, SEQ = 4096, DM = 4096, NH = 16, HD = 128, DA = 2048, DR = 2048, DIN = 10240, DFF = 11008, NGU = 2 * DFF, PLE = 256;
constexpr int M = NB * SEQ;
constexpr int COL_Q = 0, COL_K = 2048, COL_V = 4096, COL_XR = 6144, COL_GR = 8192;
constexpr float NORM_EPS = 1e-6f;
constexpr float QSCALE = 0.08838834764831845f * 1.4426950408889634f;
constexpr float C2_EXIT = 152.0f;

constexpr size_t MiB = 1u << 20;
constexpr size_t WS_CTL = 0;
constexpr size_t WS_WIN = 1 * MiB, WS_WOUT = 81 * MiB, WS_WGU = 113 * MiB, WS_WDN = 285 * MiB, WS_WPG = 371 * MiB, WS_WPP = 403 * MiB, WS_WRA = 405 * MiB, WS_WRX = WS_WRA + MiB / 2;
constexpr size_t WS_PB = 406 * MiB;
constexpr size_t WS_A1 = 414 * MiB;
constexpr size_t WS_A2 = 542 * MiB;
constexpr size_t WS_PE = 886 * MiB;
constexpr size_t WS_END = 1014 * MiB;
static_assert(WS_WIN + (size_t)DIN * DM * 2 <= WS_WOUT && WS_WOUT + (size_t)DM * DM * 2 <= WS_WGU && WS_WGU + (size_t)NGU * DM * 2 <= WS_WDN && WS_WDN + (size_t)DM * DFF * 2 <= WS_WPG && WS_WPG + (size_t)DM * DM * 2 <= WS_WPP && WS_WPP + (size_t)DM * PLE * 2 <= WS_WRA, "ws map: weights");
static_assert(WS_PB + (size_t)M * PLE * 2 <= WS_A1 && WS_A1 + (size_t)M * DM * 2 <= WS_A2 && WS_A2 + (size_t)M * DFF * 2 <= WS_PE && WS_PE + (size_t)M * DM * 2 <= WS_END, "ws map: activations");

constexpr int NWAVES = 8;
constexpr int LDS_BYTES = 147456;

#define GAS __attribute__((address_space(1)))
#define LAS __attribute__((address_space(3)))
typedef unsigned short bf16;
typedef unsigned v4u __attribute__((ext_vector_type(4)));
typedef unsigned v2u __attribute__((ext_vector_type(2)));
typedef float f32x4 __attribute__((ext_vector_type(4)));
#define LDS_WAIT() asm volatile("s_waitcnt lgkmcnt(0)" ::: "memory")
__device__ __forceinline__ unsigned f2bf(float f) { unsigned u = __builtin_bit_cast(unsigned, f); return (u + 0x7fffu + ((u >> 16) & 1u)) >> 16; }
__device__ __forceinline__ unsigned pk2(float lo, float hi) { return f2bf(lo) | (f2bf(hi) << 16); }
__device__ __forceinline__ float bf_lo(unsigned w) { return __uint_as_float(w << 16); }
__device__ __forceinline__ float bf_hi(unsigned w) { return __uint_as_float(w & 0xffff0000u); }
__device__ __forceinline__ float wave_sum(float v) {
#pragma unroll
    for (int o = 1; o < 64; o <<= 1) v += __shfl_xor(v, o);
    return v;
}

__device__ __forceinline__ void transpose_item(const float* W, int K, int N, bf16* WT, int k0, int n0, int drow0, LAS float* scr, int lane) {
#pragma unroll 8
    for (int i = 0; i < 32; ++i) { const int kk = 2 * i + (lane >> 5); scr[kk * 33 + (lane & 31)] = W[(size_t)(k0 + kk) * N + n0 + (lane & 31)]; }
    LDS_WAIT(); asm volatile("" ::: "memory");
    const int c = lane & 7;
#pragma unroll
    for (int j = 0; j < 4; ++j) { const int n = (lane >> 3) + 8 * j; const LAS float* s = scr + (8 * c) * 33 + n;
        v4u o; o.x = pk2(s[0 * 33], s[1 * 33]); o.y = pk2(s[2 * 33], s[3 * 33]); o.z = pk2(s[4 * 33], s[5 * 33]); o.w = pk2(s[6 * 33], s[7 * 33]);
        *(v4u*)(WT + (size_t)(drow0 + n) * K + k0 + 8 * c) = o; }
    LDS_WAIT(); asm volatile("" ::: "memory");
}
__device__ __forceinline__ void transpose_mat_item(const float* W, int K, int N, bf16* WT, int mode, int item, LAS float* scr, int lane) {
    const int nblk = N / 32, kb = item / nblk, nb = item % nblk, k0 = 64 * kb, n0 = 32 * nb;
    int drow0 = n0;
    if (mode == 1) drow0 = (n0 >> 7) * 256 + (n0 & 127);
    if (mode == 2) drow0 = (n0 >> 7) * 256 + 128 + (n0 & 127);
    transpose_item(W, K, N, WT, k0, n0, drow0, scr, lane);
}

__device__ __forceinline__ void rms_row_to_bf16(const float* xrow, const float* g, bf16* orow, int lane) {
    const f32x4* xr = (const f32x4*)xrow + lane;
    f32x4 v[16]; float s = 0.f;
#pragma unroll
    for (int j = 0; j < 16; ++j) { v[j] = xr[64 * j]; s += (v[j].x * v[j].x + v[j].y * v[j].y) + (v[j].z * v[j].z + v[j].w * v[j].w); }
    const float rstd = 1.0f / sqrtf(wave_sum(s) * (1.f / DM) + NORM_EPS);
    const f32x4* gr = (const f32x4*)g + lane;
    v2u* o8 = (v2u*)orow + lane;
#pragma unroll
    for (int j = 0; j < 16; ++j) { const f32x4 gg = gr[64 * j]; v2u w; w.x = pk2(v[j].x * rstd * gg.x, v[j].y * rstd * gg.y); w.y = pk2(v[j].z * rstd * gg.z, v[j].w * rstd * gg.w); o8[64 * j] = w; }
}
__device__ __forceinline__ void rms_row_f32(float* xrow, const float* g, int lane) {
    f32x4* xr = (f32x4*)xrow + lane;
    f32x4 v[16]; float s = 0.f;
#pragma unroll
    for (int j = 0; j < 16; ++j) { v[j] = xr[64 * j]; s += (v[j].x * v[j].x + v[j].y * v[j].y) + (v[j].z * v[j].z + v[j].w * v[j].w); }
    const float rstd = 1.0f / sqrtf(wave_sum(s) * (1.f / DM) + NORM_EPS);
    const f32x4* gr = (const f32x4*)g + lane;
#pragma unroll
    for (int j = 0; j < 16; ++j) { const f32x4 gg = gr[64 * j]; xr[64 * j] = (f32x4){v[j].x * rstd * gg.x, v[j].y * rstd * gg.y, v[j].z * rstd * gg.z, v[j].w * rstd * gg.w}; }
}
__device__ __forceinline__ void rms_seg2048_bf16(bf16* seg, const float* g, int lane) {
    v4u* p = (v4u*)seg + lane; v4u w[4]; float s = 0.f;
#pragma unroll
    for (int j = 0; j < 4; ++j) { w[j] = p[64 * j];
#pragma unroll
        for (int e = 0; e < 4; ++e) { const float a = bf_lo(w[j][e]), b = bf_hi(w[j][e]); s += a * a + b * b; } }
    const float rstd = 1.0f / sqrtf(wave_sum(s) * (1.f / 2048.f) + NORM_EPS);
#pragma unroll
    for (int j = 0; j < 4; ++j) { const f32x4* gp = (const f32x4*)(g + (64 * j + lane) * 8); const f32x4 g0 = gp[0], g1 = gp[1]; v4u o;
        o.x = pk2(bf_lo(w[j].x) * rstd * g0.x, bf_hi(w[j].x) * rstd * g0.y); o.y = pk2(bf_lo(w[j].y) * rstd * g0.z, bf_hi(w[j].y) * rstd * g0.w);
        o.z = pk2(bf_lo(w[j].z) * rstd * g1.x, bf_hi(w[j].z) * rstd * g1.y); o.w = pk2(bf_lo(w[j].w) * rstd * g1.z, bf_hi(w[j].w) * rstd * g1.w);
        p[64 * j] = o; }
}
__device__ __forceinline__ void rms_row4096_bf16(bf16* row, const float* g, int lane) {
    v4u* p = (v4u*)row + lane; v4u w[8]; float s = 0.f;
#pragma unroll
    for (int j = 0; j < 8; ++j) { w[j] = p[64 * j];
#pragma unroll
        for (int e = 0; e < 4; ++e) { const float a = bf_lo(w[j][e]), b = bf_hi(w[j][e]); s += a * a + b * b; } }
    const float rstd = 1.0f / sqrtf(wave_sum(s) * (1.f / 4096.f) + NORM_EPS);
#pragma unroll
    for (int j = 0; j < 8; ++j) { const f32x4* gp = (const f32x4*)(g + (64 * j + lane) * 8); const f32x4 g0 = gp[0], g1 = gp[1]; v4u o;
        o.x = pk2(bf_lo(w[j].x) * rstd * g0.x, bf_hi(w[j].x) * rstd * g0.y); o.y = pk2(bf_lo(w[j].y) * rstd * g0.z, bf_hi(w[j].y) * rstd * g0.w);
        o.z = pk2(bf_lo(w[j].z) * rstd * g1.x, bf_hi(w[j].z) * rstd * g1.y); o.w = pk2(bf_lo(w[j].w) * rstd * g1.z, bf_hi(w[j].w) * rstd * g1.w);
        p[64 * j] = o; }
}

struct Args {
    const float *x, *p, *g_mix, *w_in, *conv_w, *conv_b, *w_rg_a, *b_rg_a, *w_rg_x, *b_rg_x, *rg_lambda, *g_attn_out, *g_rnn_out, *w_out, *g_ffn, *w_ffn_gate, *w_ffn_up, *w_ffn_down, *g_ple, *w_ple_gate, *w_ple_proj, *g_ple_out, *g_final;
    float* out; unsigned char* ws;
};

__global__ void __launch_bounds__(512, 2) k_prologue(Args a) {
    extern __shared__ __attribute__((aligned(16))) unsigned char lds[];
    const int tid = threadIdx.x, lane = tid & 63, wave = tid >> 6;
    LAS float* scr = (LAS float*)((LAS unsigned char*)lds + wave * 16384);
    const int gw = blockIdx.x * NWAVES + wave, NGW = gridDim.x * NWAVES;
    unsigned char* ws = a.ws;
    constexpr int I_IN = (DM / 64) * (DIN / 32), I_OUT = (DM / 64) * (DM / 32), I_G = (DM / 64) * (DFF / 32), I_DN = (DFF / 64) * (DM / 32), I_PG = I_OUT, I_PP = (PLE / 64) * (DM / 32), I_RG = 16 * 8;
    constexpr int NITEMS = I_IN + I_OUT + 2 * I_G + I_DN + I_PG + I_PP + 2 * I_RG;
    for (int it = gw; it < NITEMS; it += NGW) {
        int r = it;
        if (r < I_IN) { transpose_mat_item(a.w_in, DM, DIN, (bf16*)(ws + WS_WIN), 0, r, scr, lane); continue; } r -= I_IN;
        if (r < I_OUT) { transpose_mat_item(a.w_out, DM, DM, (bf16*)(ws + WS_WOUT), 0, r, scr, lane); continue; } r -= I_OUT;
        if (r < I_G) { transpose_mat_item(a.w_ffn_gate, DM, DFF, (bf16*)(ws + WS_WGU), 1, r, scr, lane); continue; } r -= I_G;
        if (r < I_G) { transpose_mat_item(a.w_ffn_up, DM, DFF, (bf16*)(ws + WS_WGU), 2, r, scr, lane); continue; } r -= I_G;
        if (r < I_DN) { transpose_mat_item(a.w_ffn_down, DFF, DM, (bf16*)(ws + WS_WDN), 0, r, scr, lane); continue; } r -= I_DN;
        if (r < I_PG) { transpose_mat_item(a.w_ple_gate, DM, DM, (bf16*)(ws + WS_WPG), 0, r, scr, lane); continue; } r -= I_PG;
        if (r < I_PP) { transpose_mat_item(a.w_ple_proj, PLE, DM, (bf16*)(ws + WS_WPP), 0, r, scr, lane); continue; } r -= I_PP;
        if (r < I_RG) { const int blk = r / 8; transpose_mat_item(a.w_rg_a + (size_t)blk * 16384, 128, 128, (bf16*)(ws + WS_WRA) + (size_t)blk * 16384, 0, r % 8, scr, lane); continue; } r -= I_RG;
        { const int blk = r / 8; transpose_mat_item(a.w_rg_x + (size_t)blk * 16384, 128, 128, (bf16*)(ws + WS_WRX) + (size_t)blk * 16384, 0, r % 8, scr, lane); }
    }
    for (int m = gw; m < M; m += NGW) rms_row_to_bf16(a.x + (size_t)m * DM, a.g_mix, (bf16*)(ws + WS_A1) + (size_t)m * DM, lane);
    { const f32x4* src = (const f32x4*)a.p; v2u* dst = (v2u*)(ws + WS_PB); const size_t n4 = (size_t)M * PLE / 4;
      for (size_t i = (size_t)blockIdx.x * 512 + tid; i < n4; i += (size_t)gridDim.x * 512) { const f32x4 v = src[i]; v2u w; w.x = pk2(v.x, v.y); w.y = pk2(v.z, v.w); dst[i] = w; } }
}

template <class Epi> __global__ void __launch_bounds__(512, 2) k_gemm(pg8::Gemm g, Epi E) {
    extern __shared__ __attribute__((aligned(16))) unsigned char lds[];
    pg8::StaticOrder S; S.init(g.M, g.N, (int)gridDim.x, (int)blockIdx.x);
    pg8::gemm_phase<Epi, pg8::StaticOrder, true, true>((PG8_LAS unsigned char*)lds, g, S, E);
}

__global__ void __launch_bounds__(256) k_attn_naive(const bf16* proj, bf16* mixed) {
    const int lane = threadIdx.x & 63, gw = blockIdx.x * 4 + (threadIdx.x >> 6);
    const int t = gw % SEQ, h = (gw / SEQ) % NH, b = gw / (SEQ * NH);
    const size_t row = (size_t)b * SEQ + t;
    const unsigned qw = *(const unsigned*)(proj + row * DIN + COL_Q + h * HD + 2 * lane);
    const float q0 = bf_lo(qw), q1 = bf_hi(qw);
    float o0 = 0.f, o1 = 0.f, C = 0.f;
    for (int s = t - 1; s >= 0; --s) {
        const size_t kr = (size_t)b * SEQ + s;
        const unsigned kw = *(const unsigned*)(proj + kr * DIN + COL_K + h * HD + 2 * lane);
        const unsigned vw = *(const unsigned*)(proj + kr * DIN + COL_V + h * HD + 2 * lane);
        const float z = wave_sum(q0 * bf_lo(kw) + q1 * bf_hi(kw));
        const float sp = fmaxf(z, 0.f) + __builtin_amdgcn_logf(1.0f + __builtin_amdgcn_exp2f(-fabsf(z)));
        C += sp;
        const float w = __builtin_amdgcn_exp2f(z - C);
        o0 += w * bf_lo(vw); o1 += w * bf_hi(vw);
        if (C > C2_EXIT) break;
    }
    *(unsigned*)(mixed + row * DM + h * HD + 2 * lane) = pk2(o0, o1);
}

__global__ void __launch_bounds__(256) k_conv(const bf16* proj, const float* cw, const float* cb, bf16* xc) {
    const size_t i = (size_t)blockIdx.x * 256 + threadIdx.x;
    const int c = (int)(i % DR); const size_t row = i / DR; const int t = (int)(row % SEQ);
    float acc = cb[c];
#pragma unroll
    for (int j = 0; j < 4; ++j) { const int tt = t - 3 + j; if (tt >= 0) acc += cw[j * DR + c] * __uint_as_float((unsigned)proj[(row - 3 + j) * DIN + COL_XR + c] << 16); }
    xc[i] = (bf16)f2bf(acc);
}
__global__ void __launch_bounds__(256) k_gates(const bf16* xc, const float* wa, const float* ba, const float* wx, const float* bx, const float* lam, float* aout, float* uout) {
    const size_t i = (size_t)blockIdx.x * 256 + threadIdx.x;
    const int c = (int)(i % DR); const size_t row = i / DR; const int blk = c >> 7, j = c & 127;
    float ra = ba[c], rx = bx[c];
    const bf16* xr = xc + row * DR + blk * 128; const float* wap = wa + (size_t)blk * 16384 + j; const float* wxp = wx + (size_t)blk * 16384 + j;
    for (int k = 0; k < 128; ++k) { const float xv = __uint_as_float((unsigned)xr[k] << 16);
        ra += xv * __uint_as_float(f2bf(wap[k * 128]) << 16); rx += xv * __uint_as_float(f2bf(wxp[k * 128]) << 16); }
    const float r = 1.0f / (1.0f + expf(-ra)), ig = 1.0f / (1.0f + expf(-rx));
    const float log_a = -8.0f * r * log1pf(expf(-lam[c]));
    const float av = expf(log_a), mult = sqrtf(-expm1f(2.0f * log_a));
    aout[i] = av; uout[i] = mult * ig * __uint_as_float((unsigned)xc[i] << 16);
}
__global__ void __launch_bounds__(256) k_scan(const float* av, const float* uv, const bf16* proj, bf16* mixed) {
    const int i = blockIdx.x * 256 + threadIdx.x;
    const int c = i % DR, b = i / DR;
    float h = 0.f;
    for (int t0 = 0; t0 < SEQ; t0 += 8) {
        float aa[8], uu[8], gg[8];
#pragma unroll
        for (int k = 0; k < 8; ++k) { const size_t row = (size_t)b * SEQ + t0 + k; aa[k] = av[row * DR + c]; uu[k] = uv[row * DR + c]; gg[k] = __uint_as_float((unsigned)proj[row * DIN + COL_GR + c] << 16); }
#pragma unroll
        for (int k = 0; k < 8; ++k) { const size_t row = (size_t)b * SEQ + t0 + k; h = aa[k] * h + uu[k];
            const float g = gg[k], inner = 0.7978845608028654f * (g + 0.044715f * g * g * g), ge = 0.5f * g * (1.0f + tanhf(inner));
            mixed[row * DM + DA + c] = (bf16)f2bf(h * ge); }
    }
}
__global__ void __launch_bounds__(512) k_norm_mixed(bf16* mixed, const float* ga, const float* gr) {
    const int lane = threadIdx.x & 63, gw = blockIdx.x * NWAVES + (threadIdx.x >> 6), NGW = gridDim.x * NWAVES;
    for (int m = gw; m < M; m += NGW) { rms_seg2048_bf16(mixed + (size_t)m * DM, ga, lane); rms_seg2048_bf16(mixed + (size_t)m * DM + DA, gr, lane); }
}
__global__ void __launch_bounds__(512) k_norm_pe(bf16* pe, const float* g) {
    const int lane = threadIdx.x & 63, gw = blockIdx.x * NWAVES + (threadIdx.x >> 6), NGW = gridDim.x * NWAVES;
    for (int m = gw; m < M; m += NGW) rms_row4096_bf16(pe + (size_t)m * DM, g, lane);
}
__global__ void __launch_bounds__(512) k_norm_to_bf16(const float* h, const float* g, bf16* o) {
    const int lane = threadIdx.x & 63, gw = blockIdx.x * NWAVES + (threadIdx.x >> 6), NGW = gridDim.x * NWAVES;
    for (int m = gw; m < M; m += NGW) rms_row_to_bf16(h + (size_t)m * DM, g, o + (size_t)m * DM, lane);
}
__global__ void __launch_bounds__(512) k_norm_final(float* h, const float* g) {
    const int lane = threadIdx.x & 63, gw = blockIdx.x * NWAVES + (threadIdx.x >> 6), NGW = gridDim.x * NWAVES;
    for (int m = gw; m < M; m += NGW) rms_row_f32(h + (size_t)m * DM, g, lane);
}

template <class Epi> static void launch_gemm(const pg8::Gemm& g, const Epi& E, int grid, hipStream_t stream) {
    static bool attr = false;
    if (!attr) { (void)hipFuncSetAttribute((const void*)k_gemm<Epi>, hipFuncAttributeMaxDynamicSharedMemorySize, LDS_BYTES); attr = true; }
    hipLaunchKernelGGL((k_gemm<Epi>), dim3(grid), dim3(512), LDS_BYTES, stream, g, E);
}

extern "C" void kernel_launch(void* const* d_in, const int* in_sizes, int n_in, void* d_out, int out_size, void* d_ws, size_t ws_size, hipStream_t stream) {
    if (n_in != 23 || in_sizes[0] != M * DM || out_size != M * DM || ws_size < WS_END) { fprintf(stderr, "kernel_launch: unexpected shapes: n_in %d in0 %d out %d ws %zu (need %zu)\n", n_in, n_in > 0 ? in_sizes[0] : -1, out_size, ws_size, (size_t)WS_END); return; }
    static bool attr0 = false;
    if (!attr0) { (void)hipFuncSetAttribute((const void*)k_prologue, hipFuncAttributeMaxDynamicSharedMemorySize, LDS_BYTES); attr0 = true; }
    const int grid = 256;
    Args a{};
    const float** ap = (const float**)&a;
    for (int i = 0; i < 23; ++i) ap[i] = (const float*)d_in[i];
    a.out = (float*)d_out; a.ws = (unsigned char*)d_ws;
    unsigned char* ws = (unsigned char*)d_ws; float* out = (float*)d_out;
    bf16 *A1 = (bf16*)(ws + WS_A1), *A2 = (bf16*)(ws + WS_A2), *PE = (bf16*)(ws + WS_PE), *PB = (bf16*)(ws + WS_PB);
    hipLaunchKernelGGL(k_prologue, dim3(grid), dim3(512), LDS_BYTES, stream, a);
    launch_gemm(pg8::Gemm{A1, (const bf16*)(ws + WS_WIN), M, DIN, DM}, pg8::EpiBf16S{A2, DIN, DA / 256, QSCALE}, grid, stream);
    hipLaunchKernelGGL(k_attn_naive, dim3(NB * NH * SEQ / 4), dim3(256), 0, stream, (const bf16*)A2, A1);
    hipLaunchKernelGGL(k_conv, dim3(M * DR / 256), dim3(256), 0, stream, (const bf16*)A2, a.conv_w, a.conv_b, PE);
    hipLaunchKernelGGL(k_gates, dim3(M * DR / 256), dim3(256), 0, stream, (const bf16*)PE, a.w_rg_a, a.b_rg_a, a.w_rg_x, a.b_rg_x, a.rg_lambda, out, out + (size_t)M * DR);
    hipLaunchKernelGGL(k_scan, dim3(NB * DR / 256), dim3(256), 0, stream, (const float*)out, (const float*)(out + (size_t)M * DR), (const bf16*)A2, A1);
    hipLaunchKernelGGL(k_norm_mixed, dim3(grid), dim3(512), 0, stream, A1, a.g_attn_out, a.g_rnn_out);
    launch_gemm(pg8::Gemm{PB, (const bf16*)(ws + WS_WPP), M, DM, PLE}, pg8::EpiBf16S{PE, DM, 0, 1.f}, grid, stream);
    hipLaunchKernelGGL(k_norm_pe, dim3(grid), dim3(512), 0, stream, PE, a.g_ple_out);
    launch_gemm(pg8::Gemm{A1, (const bf16*)(ws + WS_WOUT), M, DM, DM}, pg8::EpiRes{a.x, out, DM}, grid, stream);
    hipLaunchKernelGGL(k_norm_to_bf16, dim3(grid), dim3(512), 0, stream, (const float*)out, a.g_ffn, A1);
    launch_gemm(pg8::Gemm{A1, (const bf16*)(ws + WS_WGU), M, NGU, DM}, pg8::EpiSwiGLU{A2, DFF}, grid, stream);
    launch_gemm(pg8::Gemm{A2, (const bf16*)(ws + WS_WDN), M, DM, DFF}, pg8::EpiRes{out, out, DM}, grid, stream);
    hipLaunchKernelGGL(k_norm_to_bf16, dim3(grid), dim3(512), 0, stream, (const float*)out, a.g_ple, A1);
    launch_gemm(pg8::Gemm{A1, (const bf16*)(ws + WS_WPG), M, DM, DM}, pg8::EpiPleGate{out, out, PE, DM}, grid, stream);
    hipLaunchKernelGGL(k_norm_final, dim3(grid), dim3(512), 0, stream, out, a.g_final);
}
```

```cpp
#include <hip/hip_runtime.h>
#include <cstdio>
#include <cstdint>

namespace pg8 {
#define PG8_LAS __attribute__((address_space(3)))
typedef unsigned short bf16_t;
typedef short bf16x8 __attribute__((ext_vector_type(8)));
typedef float f32x4 __attribute__((ext_vector_type(4)));
typedef unsigned u32x4 __attribute__((ext_vector_type(4)));
typedef unsigned u32x2 __attribute__((ext_vector_type(2)));
constexpr int BM = 256, BK = 64, HALF = 128, HTB = HALF * BK * 2  , STAGE_BYTES = 8 * HTB, NXCD = 8, WGM = 8;

__host__ __device__ __forceinline__ int lds_byte(int r, int c) { const int st = (r >> 4) * 2 + (c >> 5), rr = r & 15, cc = c & 31, ob = rr * 64 + cc * 2; return st * 1024 + (ob ^ (((ob >> 9) & 1) << 5)); }
__host__ __device__ __forceinline__ void stage_rc(int b, int& R, int& C) { const int st = b / 1024, sb = b % 1024, swz = sb ^ (((sb >> 9) & 1) << 5); R = (st >> 1) * 16 + swz / 64; C = (st & 1) * 32 + (swz % 64) / 2; }
__host__ __device__ __forceinline__ int perm32(int rho) { const int n = rho >> 4, i = rho & 15; return 8 * (i >> 2) + 4 * n + (i & 3); }

struct Unit { int pm, pn; };
struct Gemm { const bf16_t* A; const bf16_t* Bt; int M, N, K, pad; };

struct StaticOrder {
    int nM, nN, nwg, G, c, wgm;
    __host__ __device__ void init(int M, int N, int G_, int c_, int wgm_ = WGM) { nM = M / BM; nN = N / BM; nwg = nM * nN; G = G_; c = c_; wgm = wgm_; }
    __host__ __device__ bool next(int i, Unit& u) const {
        const long L = (long)i * G + c; if (L >= nwg) return false;
        int wgid = (int)L; { const int q = nwg / NXCD, r = nwg % NXCD, xcd = wgid % NXCD, off = wgid / NXCD; wgid = (xcd < r ? xcd * (q + 1) : r * (q + 1) + (xcd - r) * q) + off; }
        const int nig = wgm * nN, gid = wgid / nig, fm = gid * wgm, gsz = (nM - fm) < wgm ? (nM - fm) : wgm;
        u.pm = fm + ((wgid % nig) % gsz); u.pn = (wgid % nig) / gsz; return true;
    }
    __device__ __forceinline__ void a_ready(const Unit&) const {}
    __device__ __forceinline__ void done(const Unit&) const {}
};

__device__ __forceinline__ unsigned cvt_pk_bf16(float lo, float hi) { unsigned r; asm volatile("v_cvt_pk_bf16_f32 %0, %1, %2" : "=v"(r) : "v"(lo), "v"(hi)); return r; }

struct EpiBf16S {
    static constexpr bool PERM = true, AFTER_DRAIN = false;
    bf16_t* O; const float* rs; int ldc; int nscale; float sc; int pad;
    __device__ __forceinline__ void operator()(const f32x4 (&acc)[2][2][4][2], const Unit& u, int wr, int wc, int fr_in, int fq_in) const {
        int fr = fr_in, fq = fq_in; asm volatile("" : "+v"(fr), "+v"(fq));
        const int row0 = u.pm * BM + wr * 64 + fr, col0 = u.pn * BM + wc * 32 + 8 * fq;
        const float s = (u.pn < nscale) ? sc : 1.f;
#pragma unroll
        for (int ai = 0; ai < 2; ++ai)
#pragma unroll
            for (int m = 0; m < 4; ++m) { const int row = row0 + ai * HALF + m * 16; bf16_t* rowp = O + (size_t)row * ldc + col0; const float sr = rs ? s * rs[row] : s;
#pragma unroll
                for (int bj = 0; bj < 2; ++bj) { const f32x4 v0 = acc[ai][bj][m][0] * sr, v1 = acc[ai][bj][m][1] * sr;
                    u32x4 w; w.x = cvt_pk_bf16(v0[0], v0[1]); w.y = cvt_pk_bf16(v0[2], v0[3]); w.z = cvt_pk_bf16(v1[0], v1[1]); w.w = cvt_pk_bf16(v1[2], v1[3]);
                    *(u32x4*)(rowp + bj * HALF) = w; } }
    }
};
__device__ __forceinline__ float ss_to_rstd(unsigned long long v, float inv_n, float eps) { return __builtin_amdgcn_rsqf((float)v * (1.0f / 16777216.0f) * inv_n + eps); }
template <int K> __device__ __forceinline__ float sxf(float v) { return __int_as_float(__builtin_amdgcn_ds_swizzle(__float_as_int(v), (K << 10) | 0x1f)); }
template <int K> __device__ __forceinline__ unsigned sxu(unsigned v) { return (unsigned)__builtin_amdgcn_ds_swizzle((int)v, (K << 10) | 0x1f); }
__device__ __forceinline__ float sum32(float v) { auto r = __builtin_amdgcn_permlane32_swap(__float_as_uint(v), __float_as_uint(v), false, false); return __uint_as_float(r[0]) + __uint_as_float(r[1]); }
__device__ __forceinline__ float max32(float v) { auto r = __builtin_amdgcn_permlane32_swap(__float_as_uint(v), __float_as_uint(v), false, false); return fmaxf(__uint_as_float(r[0]), __uint_as_float(r[1])); }
template <bool BASE_BF, bool WIDE = true, bool SSQ = true> struct EpiRes {
    static_assert(BASE_BF, "the base is bf16: the layer input x is cast once in the prologue");
    static constexpr bool PERM = true, AFTER_DRAIN = false;
    const float* base; bf16_t* hb; unsigned long long* ss; unsigned char* h8; const bf16_t* bsrc; int ldc; float ascale;
    __device__ __forceinline__ void operator()(const f32x4 (&acc)[2][2][4][2], const Unit& u, int wr, int wc, int fr_in, int fq_in, const float (*rsr)[4] = nullptr) const {
        int fr = fr_in, fq = fq_in; asm volatile("" : "+v"(fr), "+v"(fq));
        const int row0 = u.pm * BM + wr * 64 + fr, col0 = u.pn * BM + wc * 32 + 8 * fq;
        const bf16_t* src = bsrc ? bsrc : hb;
        u32x4 bw[2][4][2];
        if constexpr (WIDE) {
#pragma unroll
        for (int ai = 0; ai < 2; ++ai)
#pragma unroll
            for (int m = 0; m < 4; ++m) { const size_t off = (size_t)(row0 + ai * HALF + m * 16) * ldc + col0;
#pragma unroll
                for (int bj = 0; bj < 2; ++bj) bw[ai][m][bj] = *(const u32x4*)(src + off + bj * HALF); }
        }
#pragma unroll
        for (int ai = 0; ai < 2; ++ai) {
            if constexpr (!WIDE) {
#pragma unroll
                for (int m = 0; m < 4; ++m) { const size_t off = (size_t)(row0 + ai * HALF + m * 16) * ldc + col0;
#pragma unroll
                    for (int bj = 0; bj < 2; ++bj) bw[ai][m][bj] = *(const u32x4*)(src + off + bj * HALF); }
            }
#pragma unroll
            for (int m = 0; m < 4; ++m) { const int row = row0 + ai * HALF + m * 16; const size_t off = (size_t)row * ldc + col0; const float ascale = rsr ? this->ascale * rsr[ai][m] : this->ascale;
                float s = 0.f;
#pragma unroll
                for (int bj = 0; bj < 2; ++bj) { const u32x4 b = bw[ai][m][bj];
                    const f32x4 o0 = (f32x4){__uint_as_float(b[0] << 16), __uint_as_float(b[0] & 0xffff0000u), __uint_as_float(b[1] << 16), __uint_as_float(b[1] & 0xffff0000u)} + acc[ai][bj][m][0] * ascale;
                    const f32x4 o1 = (f32x4){__uint_as_float(b[2] << 16), __uint_as_float(b[2] & 0xffff0000u), __uint_as_float(b[3] << 16), __uint_as_float(b[3] & 0xffff0000u)} + acc[ai][bj][m][1] * ascale;
                    u32x4 w; w.x = cvt_pk_bf16(o0[0], o0[1]); w.y = cvt_pk_bf16(o0[2], o0[3]); w.z = cvt_pk_bf16(o1[0], o1[1]); w.w = cvt_pk_bf16(o1[2], o1[3]);
                    *(u32x4*)(hb + off + bj * HALF) = w;
                    if (h8) { int q0 = 0, q1 = 0;
                        q0 = __builtin_amdgcn_cvt_pk_fp8_f32(__builtin_amdgcn_fmed3f(o0[0], -448.f, 448.f), __builtin_amdgcn_fmed3f(o0[1], -448.f, 448.f), q0, false);
                        q0 = __builtin_amdgcn_cvt_pk_fp8_f32(__builtin_amdgcn_fmed3f(o0[2], -448.f, 448.f), __builtin_amdgcn_fmed3f(o0[3], -448.f, 448.f), q0, true);
                        q1 = __builtin_amdgcn_cvt_pk_fp8_f32(__builtin_amdgcn_fmed3f(o1[0], -448.f, 448.f), __builtin_amdgcn_fmed3f(o1[1], -448.f, 448.f), q1, false);
                        q1 = __builtin_amdgcn_cvt_pk_fp8_f32(__builtin_amdgcn_fmed3f(o1[2], -448.f, 448.f), __builtin_amdgcn_fmed3f(o1[3], -448.f, 448.f), q1, true);
                        *(u32x2*)(h8 + off + bj * HALF) = (u32x2){(unsigned)q0, (unsigned)q1}; }
                    if constexpr (SSQ) s += (o0[0] * o0[0] + o0[1] * o0[1]) + (o0[2] * o0[2] + o0[3] * o0[3]) + (o1[0] * o1[0] + o1[1] * o1[1]) + (o1[2] * o1[2] + o1[3] * o1[3]); }
                if constexpr (SSQ) { s += sxf<16>(s); s = sum32(s);
                    if (fq == 0) atomicAdd(ss + row, (unsigned long long)(s * 16777216.0f)); } }
            if constexpr (!WIDE) asm volatile("" ::: "memory");
        }
    }
};
struct EpiPe {
    static constexpr bool PERM = true, AFTER_DRAIN = false;
    bf16_t* O; const float* g; float* part; int ldc; int pad;
    __device__ __forceinline__ void operator()(const f32x4 (&acc)[2][2][4][2], const Unit& u, int wr, int wc, int fr_in, int fq_in) const {
        int fr = fr_in, fq = fq_in; asm volatile("" : "+v"(fr), "+v"(fq));
        const int row0 = u.pm * BM + wr * 64 + fr, col0 = u.pn * BM + wc * 32 + 8 * fq;
        f32x4 gc[2][2];
#pragma unroll
        for (int bj = 0; bj < 2; ++bj) { gc[bj][0] = *(const f32x4*)(g + col0 + bj * HALF); gc[bj][1] = *(const f32x4*)(g + col0 + bj * HALF + 4); }
#pragma unroll
        for (int ai = 0; ai < 2; ++ai)
#pragma unroll
            for (int m = 0; m < 4; ++m) { const int row = row0 + ai * HALF + m * 16; bf16_t* rowp = O + (size_t)row * ldc + col0; float s = 0.f;
#pragma unroll
                for (int bj = 0; bj < 2; ++bj) { const f32x4 a0 = acc[ai][bj][m][0], a1 = acc[ai][bj][m][1];
                    s += (a0[0] * a0[0] + a0[1] * a0[1]) + (a0[2] * a0[2] + a0[3] * a0[3]) + (a1[0] * a1[0] + a1[1] * a1[1]) + (a1[2] * a1[2] + a1[3] * a1[3]);
                    const f32x4 v0 = a0 * gc[bj][0], v1 = a1 * gc[bj][1];
                    u32x4 w; w.x = cvt_pk_bf16(v0[0], v0[1]); w.y = cvt_pk_bf16(v0[2], v0[3]); w.z = cvt_pk_bf16(v1[0], v1[1]); w.w = cvt_pk_bf16(v1[2], v1[3]);
                    *(u32x4*)(rowp + bj * HALF) = w; }
                s += sxf<16>(s); s = sum32(s);
                if (fq == 0) part[(size_t)row * 64 + u.pn * 4 + wc] = s; }
    }
};
struct EpiSwiGLU {
    static constexpr bool PERM = true, AFTER_DRAIN = false;
    unsigned char* O; const unsigned long long* ss; int pitch; int k1;
    __device__ __forceinline__ void operator()(const f32x4 (&acc)[2][2][4][2], const Unit& u, int wr, int wc, int fr_in, int fq_in) const {
        int fr = fr_in, fq = fq_in; asm volatile("" : "+v"(fr), "+v"(fq));
        const int row0 = u.pm * BM + wr * 64 + fr, col0 = u.pn * HALF + wc * 32 + 8 * fq;
        float rs[2][4];
#pragma unroll
        for (int ai = 0; ai < 2; ++ai)
#pragma unroll
            for (int m = 0; m < 4; ++m) rs[ai][m] = ss_to_rstd(ss[row0 + ai * HALF + m * 16], 1.0f / 4096.0f, 1e-6f);
#pragma unroll
        for (int ai = 0; ai < 2; ++ai)
#pragma unroll
            for (int m = 0; m < 4; ++m) { unsigned char* rowp = O + (size_t)(row0 + ai * HALF + m * 16) * pitch;
                float r[8];
#pragma unroll
                for (int n = 0; n < 2; ++n)
#pragma unroll
                    for (int j = 0; j < 4; ++j) { const float g = acc[ai][0][m][n][j] * rs[ai][m], up = acc[ai][1][m][n][j] * rs[ai][m];
                        const float e = __builtin_amdgcn_exp2f(-1.4426950408889634f * g); r[n * 4 + j] = g * __builtin_amdgcn_rcpf(1.0f + e) * (up * 16.0f); }
                if (u.pn * HALF < k1) { int q0 = 0, q1 = 0;
                    q0 = __builtin_amdgcn_cvt_pk_fp8_f32(__builtin_amdgcn_fmed3f(r[0], -448.f, 448.f), __builtin_amdgcn_fmed3f(r[1], -448.f, 448.f), q0, false);
                    q0 = __builtin_amdgcn_cvt_pk_fp8_f32(__builtin_amdgcn_fmed3f(r[2], -448.f, 448.f), __builtin_amdgcn_fmed3f(r[3], -448.f, 448.f), q0, true);
                    q1 = __builtin_amdgcn_cvt_pk_fp8_f32(__builtin_amdgcn_fmed3f(r[4], -448.f, 448.f), __builtin_amdgcn_fmed3f(r[5], -448.f, 448.f), q1, false);
                    q1 = __builtin_amdgcn_cvt_pk_fp8_f32(__builtin_amdgcn_fmed3f(r[6], -448.f, 448.f), __builtin_amdgcn_fmed3f(r[7], -448.f, 448.f), q1, true);
                    *(u32x2*)(rowp + col0) = (u32x2){(unsigned)q0, (unsigned)q1};
                } else { u32x4 w; w.x = cvt_pk_bf16(r[0], r[1]); w.y = cvt_pk_bf16(r[2], r[3]); w.z = cvt_pk_bf16(r[4], r[5]); w.w = cvt_pk_bf16(r[6], r[7]);
                    *(u32x4*)(rowp + k1 + 2 * (col0 - k1)) = w; } }
    }
};
typedef int v4i_e __attribute__((ext_vector_type(4)));
struct EpiBf16Si8 {
    static constexpr bool PERM = true, AFTER_DRAIN = false;
    bf16_t* O; const float* rs; const float* sb; int ldc; int nscale; float sc; int pad;
    struct Pre {}; __device__ __forceinline__ Pre pre(const Unit&, int, int, int, int) const { return Pre{}; }
    __device__ __forceinline__ void operator()(const v4i_e (&acc)[2][2][4][2], const Unit& u, int wr, int wc, int fr_in, int fq_in, const Pre&) const {
        int fr = fr_in, fq = fq_in; asm volatile("" : "+v"(fr), "+v"(fq));
        const int row0 = u.pm * BM + wr * 64 + fr, col0 = u.pn * BM + wc * 32 + 8 * fq;
        const float s = (u.pn < nscale) ? sc : 1.f;
        f32x4 cs[2][2];
#pragma unroll
        for (int bj = 0; bj < 2; ++bj) { cs[bj][0] = *(const f32x4*)(sb + col0 + bj * HALF) * s; cs[bj][1] = *(const f32x4*)(sb + col0 + bj * HALF + 4) * s; }
#pragma unroll
        for (int ai = 0; ai < 2; ++ai)
#pragma unroll
            for (int m = 0; m < 4; ++m) { const int row = row0 + ai * HALF + m * 16; bf16_t* rowp = O + (size_t)row * ldc + col0; const float sr = rs[row];
#pragma unroll
                for (int bj = 0; bj < 2; ++bj) { const f32x4 v0 = __builtin_convertvector(acc[ai][bj][m][0], f32x4) * (cs[bj][0] * sr), v1 = __builtin_convertvector(acc[ai][bj][m][1], f32x4) * (cs[bj][1] * sr);
                    u32x4 w; w.x = cvt_pk_bf16(v0[0], v0[1]); w.y = cvt_pk_bf16(v0[2], v0[3]); w.z = cvt_pk_bf16(v1[0], v1[1]); w.w = cvt_pk_bf16(v1[2], v1[3]);
                    *(u32x4*)(rowp + bj * HALF) = w; } }
    }
};
struct EpiSwiGLUi8 {
    static constexpr bool PERM = true, AFTER_DRAIN = false;
    unsigned char* O; const float* sa; const float* sb; int pitch; int k1;
    struct Pre { float rs[2][4]; f32x4 sg[2], su[2]; };
    __device__ __forceinline__ Pre pre(const Unit& u, int wr, int wc, int fr_in, int fq_in) const {
        int fr = fr_in, fq = fq_in; asm volatile("" : "+v"(fr), "+v"(fq));
        const int row0 = u.pm * BM + wr * 64 + fr, wrow = u.pn * BM + wc * 32 + 8 * fq;
        Pre p;
        p.sg[0] = *(const f32x4*)(sb + wrow); p.sg[1] = *(const f32x4*)(sb + wrow + 4); p.su[0] = *(const f32x4*)(sb + wrow + HALF); p.su[1] = *(const f32x4*)(sb + wrow + HALF + 4);
#pragma unroll
        for (int ai = 0; ai < 2; ++ai)
#pragma unroll
            for (int m = 0; m < 4; ++m) p.rs[ai][m] = sa[row0 + ai * HALF + m * 16];
        return p;
    }
    __device__ __forceinline__ void operator()(const v4i_e (&acc)[2][2][4][2], const Unit& u, int wr, int wc, int fr_in, int fq_in, const Pre& p) const {
        int fr = fr_in, fq = fq_in; asm volatile("" : "+v"(fr), "+v"(fq));
        const int row0 = u.pm * BM + wr * 64 + fr, col0 = u.pn * HALF + wc * 32 + 8 * fq;
#pragma unroll
        for (int ai = 0; ai < 2; ++ai)
#pragma unroll
            for (int m = 0; m < 4; ++m) { unsigned char* rowp = O + (size_t)(row0 + ai * HALF + m * 16) * pitch;
                float r[8];
#pragma unroll
                for (int n = 0; n < 2; ++n)
#pragma unroll
                    for (int j = 0; j < 4; ++j) { const float g = (float)acc[ai][0][m][n][j] * (p.rs[ai][m] * p.sg[n][j]), up = (float)acc[ai][1][m][n][j] * (p.rs[ai][m] * p.su[n][j]);
                        const float e = __builtin_amdgcn_exp2f(-1.4426950408889634f * g); r[n * 4 + j] = g * __builtin_amdgcn_rcpf(1.0f + e) * (up * 16.0f); }
                if (u.pn * HALF < k1) { int q0 = 0, q1 = 0;
                    q0 = __builtin_amdgcn_cvt_pk_fp8_f32(__builtin_amdgcn_fmed3f(r[0], -448.f, 448.f), __builtin_amdgcn_fmed3f(r[1], -448.f, 448.f), q0, false);
                    q0 = __builtin_amdgcn_cvt_pk_fp8_f32(__builtin_amdgcn_fmed3f(r[2], -448.f, 448.f), __builtin_amdgcn_fmed3f(r[3], -448.f, 448.f), q0, true);
                    q1 = __builtin_amdgcn_cvt_pk_fp8_f32(__builtin_amdgcn_fmed3f(r[4], -448.f, 448.f), __builtin_amdgcn_fmed3f(r[5], -448.f, 448.f), q1, false);
                    q1 = __builtin_amdgcn_cvt_pk_fp8_f32(__builtin_amdgcn_fmed3f(r[6], -448.f, 448.f), __builtin_amdgcn_fmed3f(r[7], -448.f, 448.f), q1, true);
                    *(u32x2*)(rowp + col0) = (u32x2){(unsigned)q0, (unsigned)q1};
                } else { u32x4 w; w.x = cvt_pk_bf16(r[0], r[1]); w.y = cvt_pk_bf16(r[2], r[3]); w.z = cvt_pk_bf16(r[4], r[5]); w.w = cvt_pk_bf16(r[6], r[7]);
                    *(u32x4*)(rowp + k1 + 2 * (col0 - k1)) = w; } }
    }
};
struct EpiPleGate {
    static constexpr bool PERM = true, AFTER_DRAIN = false;
    const bf16_t* hb; bf16_t* out; const bf16_t* pe; const unsigned long long* ss; const float* rspe; int ldc; int pad;
    __device__ __forceinline__ void operator()(const f32x4 (&acc)[2][2][4][2], const Unit& u, int wr, int wc, int fr_in, int fq_in) const {
        int fr = fr_in, fq = fq_in; asm volatile("" : "+v"(fr), "+v"(fq));
        const int row0 = u.pm * BM + wr * 64 + fr, col0 = u.pn * BM + wc * 32 + 8 * fq;
        float rs[2][4];
#pragma unroll
        for (int ai = 0; ai < 2; ++ai)
#pragma unroll
            for (int m = 0; m < 4; ++m) rs[ai][m] = (-1.4426950408889634f / 128.0f) * ss_to_rstd(ss[row0 + ai * HALF + m * 16], 1.0f / 4096.0f, 1e-6f);
#pragma unroll
        for (int ai = 0; ai < 2; ++ai)
#pragma unroll
        for (int mh = 0; mh < 2; ++mh) {
            u32x4 bw[2][2], pv[2][2]; float rp[2];
#pragma unroll
            for (int mm = 0; mm < 2; ++mm) { const int m = mh * 2 + mm; const size_t off = (size_t)(row0 + ai * HALF + m * 16) * ldc + col0;
#pragma unroll
                for (int bj = 0; bj < 2; ++bj) { bw[mm][bj] = *(const u32x4*)(hb + off + bj * HALF); pv[mm][bj] = *(const u32x4*)(pe + off + bj * HALF); }
                rp[mm] = rspe[row0 + ai * HALF + m * 16]; }
#pragma unroll
            for (int mm = 0; mm < 2; ++mm) { const int m = mh * 2 + mm; const size_t off = (size_t)(row0 + ai * HALF + m * 16) * ldc + col0;
#pragma unroll
                for (int bj = 0; bj < 2; ++bj) { float o[8];
#pragma unroll
                    for (int n = 0; n < 2; ++n) { const f32x4 a = acc[ai][bj][m][n]; const unsigned h0 = bw[mm][bj][2 * n], h1 = bw[mm][bj][2 * n + 1], w0 = pv[mm][bj][2 * n], w1 = pv[mm][bj][2 * n + 1];
                        o[4 * n + 0] = __uint_as_float(h0 << 16) + __builtin_amdgcn_rcpf(1.0f + __builtin_amdgcn_exp2f(rs[ai][m] * a[0])) * (rp[mm] * __uint_as_float(w0 << 16));
                        o[4 * n + 1] = __uint_as_float(h0 & 0xffff0000u) + __builtin_amdgcn_rcpf(1.0f + __builtin_amdgcn_exp2f(rs[ai][m] * a[1])) * (rp[mm] * __uint_as_float(w0 & 0xffff0000u));
                        o[4 * n + 2] = __uint_as_float(h1 << 16) + __builtin_amdgcn_rcpf(1.0f + __builtin_amdgcn_exp2f(rs[ai][m] * a[2])) * (rp[mm] * __uint_as_float(w1 << 16));
                        o[4 * n + 3] = __uint_as_float(h1 & 0xffff0000u) + __builtin_amdgcn_rcpf(1.0f + __builtin_amdgcn_exp2f(rs[ai][m] * a[3])) * (rp[mm] * __uint_as_float(w1 & 0xffff0000u)); }
                    u32x4 w; w.x = cvt_pk_bf16(o[0], o[1]); w.y = cvt_pk_bf16(o[2], o[3]); w.z = cvt_pk_bf16(o[4], o[5]); w.w = cvt_pk_bf16(o[6], o[7]);
                    *(u32x4*)(out + off + bj * HALF) = w; } }
            asm volatile("" ::: "memory");
        }
    }
};

template <class...> using pg8_void_t = void;
template <class E, class = void> struct epi_midk { static constexpr bool value = false; };
template <class E> struct epi_midk<E, pg8_void_t<decltype(E::MIDK)>> { static constexpr bool value = E::MIDK; };
struct EpiResMid : EpiRes<true, true, false> {
    static constexpr bool MIDK = true;
    const float* rat; const float* rsr;
    __device__ __forceinline__ void pre_rows(const Unit& u, int wr, int fr_in, float (&rat_)[2][4], float (&rs_)[2][4]) const {
        int fr = fr_in; asm volatile("" : "+v"(fr));
#pragma unroll
        for (int ai = 0; ai < 2; ++ai)
#pragma unroll
            for (int m = 0; m < 4; ++m) { const int row = u.pm * BM + wr * 64 + fr + ai * HALF + m * 16; rat_[ai][m] = rat[row]; rs_[ai][m] = rsr[row]; }
    }
};
template <class Epi, class Sched, bool ALIGN_EPI = false, bool SP2 = false, bool REVK = false>
__device__ __forceinline__ void gemm_phase(PG8_LAS unsigned char* lds, const Gemm g, const Sched& S, const Epi& E) {
    int tid_ = threadIdx.x; asm volatile("" : "+v"(tid_));
    const int tid = tid_, wid = __builtin_amdgcn_readfirstlane(tid >> 6), lane = tid & 63, wr = wid >> 2, wc = wid & 3, fr = lane & 15, fq = lane >> 4;
    const int K = g.K, nt = K / BK;
    const __amdgpu_buffer_rsrc_t rA = __builtin_amdgcn_make_buffer_rsrc((void*)g.A, 0, g.M * K * 2, 0x00020000), rB = __builtin_amdgcn_make_buffer_rsrc((void*)g.Bt, 0, g.N * K * 2, 0x00020000);
    int voffA[2], voffB[2];
#pragma unroll
    for (int i = 0; i < 2; ++i) { int R, C; stage_rc(tid * 16 + i * 8192, R, C); const int Rb = Epi::PERM ? ((R & ~31) + perm32(R & 31)) : R;
        voffA[i] = (R * K + C) * 2; voffB[i] = (Rb * K + C) * 2; }
    const int kstep = REVK ? -(BK * 2) : BK * 2, hstep = HALF * K * 2, tstep = 2 * hstep, k0off = REVK ? (nt - 1) * BK * 2 : 0;
    const unsigned ldsw = (unsigned)wid * 1024u;
    const int aoff = lds_byte(wr * 64 + fr, fq * 8), boff = lds_byte(wc * 32 + fr, fq * 8);
#define PG8_SA(b, h) (((b) * 2 + (h)) * HTB)
#define PG8_SB(b, h) ((4 + (b) * 2 + (h)) * HTB)
#define PG8_STAGE(bufoff, rsrc, soff, voff) do { _Pragma("unroll") for (int _i = 0; _i < 2; ++_i) \
        __builtin_amdgcn_raw_ptr_buffer_load_lds(rsrc, (PG8_LAS unsigned*)(lds + (bufoff) + ldsw + _i * 8192), 16, (voff)[_i], (soff), 0, 0); } while (0)
#define PG8_LDA(dst, b, h) do { _Pragma("unroll") for (int m = 0; m < 4; ++m) _Pragma("unroll") for (int k = 0; k < 2; ++k) dst[m][k] = *(const PG8_LAS bf16x8*)(lds + PG8_SA(b, h) + aoff + m * 2048 + k * 1024); } while (0)
#define PG8_LDB(dst, b, h) do { _Pragma("unroll") for (int n = 0; n < 2; ++n) _Pragma("unroll") for (int k = 0; k < 2; ++k) dst[n][k] = *(const PG8_LAS bf16x8*)(lds + PG8_SB(b, h) + boff + n * 2048 + k * 1024); } while (0)
#define PG8_MMA(ai, bj, At, Bt) do { __builtin_amdgcn_s_setprio(1); _Pragma("unroll") for (int m = 0; m < 4; ++m) _Pragma("unroll") for (int n = 0; n < 2; ++n) _Pragma("unroll") for (int k = 0; k < 2; ++k) \
        acc[ai][bj][m][n] = __builtin_amdgcn_mfma_f32_16x16x32_bf16(Bt[n][k], At[m][k], acc[ai][bj][m][n], 0, 0, 0); __builtin_amdgcn_s_setprio(0); } while (0)
#define PG8_WAIT_V(n) asm volatile("s_waitcnt vmcnt(" #n ")" ::: "memory")
#define PG8_WAIT_L(n) asm volatile("s_waitcnt lgkmcnt(" #n ")" ::: "memory")
#define PG8_BAR __builtin_amdgcn_s_barrier()
#define PG8_SCHED __builtin_amdgcn_sched_barrier(0)
    Unit cur, nxt; int ui = 0;
    if (!S.next(0, cur)) return;
    f32x4 acc[2][2][4][2];
#pragma unroll
    for (int a = 0; a < 2; ++a)
#pragma unroll
        for (int b = 0; b < 2; ++b)
#pragma unroll
            for (int m = 0; m < 4; ++m)
#pragma unroll
                for (int n = 0; n < 2; ++n) acc[a][b][m][n] = (f32x4){0.f, 0.f, 0.f, 0.f};
    bf16x8 At[4][2], B0[2][2], B1[2][2];
    int cA = cur.pm * tstep + k0off, cB = cur.pn * tstep + k0off;
    S.a_ready(cur);
    if constexpr (SP2) {
        PG8_STAGE(PG8_SB(0, 0), rB, cB, voffB); PG8_STAGE(PG8_SB(0, 1), rB, cB + hstep, voffB); PG8_STAGE(PG8_SA(0, 0), rA, cA, voffA); PG8_STAGE(PG8_SA(0, 1), rA, cA + hstep, voffA);
        if (wr == 1) PG8_BAR;
        PG8_WAIT_V(2); PG8_BAR;
        PG8_STAGE(PG8_SB(1, 0), rB, cB + kstep, voffB); PG8_STAGE(PG8_SA(1, 0), rA, cA + kstep, voffA); PG8_STAGE(PG8_SB(1, 1), rB, cB + hstep + kstep, voffB);
        PG8_WAIT_V(6); PG8_BAR;
    } else {
        PG8_STAGE(PG8_SB(0, 0), rB, cB, voffB); PG8_STAGE(PG8_SA(0, 0), rA, cA, voffA); PG8_STAGE(PG8_SB(0, 1), rB, cB + hstep, voffB); PG8_STAGE(PG8_SA(0, 1), rA, cA + hstep, voffA);
        if (wr == 1) PG8_BAR;
        PG8_WAIT_V(4); PG8_BAR;
        PG8_STAGE(PG8_SB(1, 0), rB, cB + kstep, voffB); PG8_STAGE(PG8_SA(1, 0), rA, cA + kstep, voffA); PG8_STAGE(PG8_SB(1, 1), rB, cB + hstep + kstep, voffB);
        PG8_WAIT_V(6); PG8_BAR;
    }
    for (;;) {
        const bool has_next = S.next(ui + 1, nxt);
        const int nA = has_next ? nxt.pm * tstep + k0off : cA, nB = has_next ? nxt.pn * tstep + k0off : cB;
        constexpr bool MIDK = epi_midk<Epi>::value;
        float mk_rat[2][4], mk_rs[2][4];
        if constexpr (MIDK) E.pre_rows(cur, wr, fr, mk_rat, mk_rs);
        for (int hf = 0; hf < (MIDK ? 2 : 1); ++hf) {
        const int tb = MIDK ? hf * (nt / 2) : 0, te = MIDK ? tb + nt / 2 : nt;
        for (int t = tb; t < te; t += 2) {
            const bool last = (t == nt - 2);
            const int a1 = cA + (t + 1) * kstep;
            const int a2 = last ? nA : cA + (t + 2) * kstep, b2 = last ? nB : cB + (t + 2) * kstep;
            const int a3 = a2 + kstep, b3 = b2 + kstep;
            if (last && has_next) S.a_ready(nxt);
            if constexpr (SP2) {
            PG8_LDB(B0, 0, 0); PG8_LDB(B1, 0, 1); PG8_SCHED; PG8_LDA(At, 0, 0); PG8_STAGE(PG8_SA(1, 1), rA, a1 + hstep, voffA);
            PG8_WAIT_V(8); PG8_WAIT_L(0); PG8_BAR; PG8_MMA(0, 0, At, B0); PG8_MMA(0, 1, At, B1); PG8_BAR; PG8_SCHED;
            PG8_LDA(At, 0, 1); PG8_STAGE(PG8_SB(0, 0), rB, b2, voffB); PG8_STAGE(PG8_SB(0, 1), rB, b2 + hstep, voffB); PG8_STAGE(PG8_SA(0, 0), rA, a2, voffA);
            PG8_WAIT_V(8); PG8_WAIT_L(0); PG8_BAR; PG8_MMA(1, 0, At, B0); PG8_MMA(1, 1, At, B1); PG8_BAR; PG8_SCHED;
            PG8_LDB(B0, 1, 0); PG8_LDB(B1, 1, 1); PG8_SCHED; PG8_LDA(At, 1, 0); PG8_STAGE(PG8_SA(0, 1), rA, a2 + hstep, voffA);
            PG8_WAIT_V(8); PG8_WAIT_L(0); PG8_BAR; PG8_MMA(0, 0, At, B0); PG8_MMA(0, 1, At, B1); PG8_BAR; PG8_SCHED;
            PG8_LDA(At, 1, 1); PG8_STAGE(PG8_SB(1, 0), rB, b3, voffB); PG8_STAGE(PG8_SB(1, 1), rB, b3 + hstep, voffB); PG8_STAGE(PG8_SA(1, 0), rA, a3, voffA);
            PG8_WAIT_V(8); PG8_WAIT_L(0); PG8_BAR; PG8_MMA(1, 0, At, B0); PG8_MMA(1, 1, At, B1); PG8_BAR; PG8_SCHED;
            } else {
            PG8_LDB(B0, 0, 0); PG8_SCHED; PG8_LDA(At, 0, 0); PG8_STAGE(PG8_SA(1, 1), rA, a1 + hstep, voffA);
            PG8_WAIT_L(8); PG8_BAR; PG8_WAIT_L(0); PG8_MMA(0, 0, At, B0); PG8_BAR; PG8_SCHED;
            PG8_LDB(B1, 0, 1); PG8_STAGE(PG8_SB(0, 0), rB, b2, voffB);
            PG8_BAR; PG8_WAIT_L(0); PG8_MMA(0, 1, At, B1); PG8_BAR;
            PG8_LDA(At, 0, 1); PG8_STAGE(PG8_SA(0, 0), rA, a2, voffA);
            PG8_BAR; PG8_WAIT_L(0); PG8_MMA(1, 0, At, B0); PG8_BAR; PG8_SCHED;
            PG8_STAGE(PG8_SB(0, 1), rB, b2 + hstep, voffB);
            PG8_WAIT_V(6); PG8_BAR; PG8_MMA(1, 1, At, B1); PG8_BAR;
            PG8_LDB(B0, 1, 0); PG8_SCHED; PG8_LDA(At, 1, 0); PG8_STAGE(PG8_SA(0, 1), rA, a2 + hstep, voffA);
            PG8_WAIT_L(8); PG8_BAR; PG8_WAIT_L(0); PG8_MMA(0, 0, At, B0); PG8_BAR; PG8_SCHED;
            PG8_LDB(B1, 1, 1); PG8_STAGE(PG8_SB(1, 0), rB, b3, voffB);
            PG8_BAR; PG8_WAIT_L(0); PG8_MMA(0, 1, At, B1); PG8_BAR;
            PG8_LDA(At, 1, 1); PG8_STAGE(PG8_SA(1, 0), rA, a3, voffA);
            PG8_BAR; PG8_WAIT_L(0); PG8_MMA(1, 0, At, B0); PG8_BAR; PG8_SCHED;
            PG8_STAGE(PG8_SB(1, 1), rB, b3 + hstep, voffB);
            PG8_WAIT_V(6); PG8_BAR; PG8_MMA(1, 1, At, B1); PG8_BAR;
            }
        }
        if constexpr (MIDK) { if (hf == 0) {
#pragma unroll
            for (int a = 0; a < 2; ++a)
#pragma unroll
                for (int b = 0; b < 2; ++b)
#pragma unroll
                    for (int m = 0; m < 4; ++m)
#pragma unroll
                        for (int n = 0; n < 2; ++n) acc[a][b][m][n] *= mk_rat[a][m]; } }
        }
        if constexpr (ALIGN_EPI) { if (wr == 0) PG8_BAR; }
        if constexpr (!Epi::AFTER_DRAIN) { if constexpr (MIDK) E(acc, cur, wr, wc, fr, fq, mk_rs); else E(acc, cur, wr, wc, fr, fq); S.done(cur); }
        if (!has_next) break;
#pragma unroll
        for (int a = 0; a < 2; ++a)
#pragma unroll
            for (int b = 0; b < 2; ++b)
#pragma unroll
                for (int m = 0; m < 4; ++m)
#pragma unroll
                    for (int n = 0; n < 2; ++n) acc[a][b][m][n] = (f32x4){0.f, 0.f, 0.f, 0.f};
        cur = nxt; cA = nA; cB = nB; ++ui;
        if constexpr (ALIGN_EPI) { if (wr == 1) PG8_BAR; }
    }
    PG8_WAIT_V(0);
    if constexpr (!ALIGN_EPI) { if (wr == 0) PG8_BAR; }
    PG8_BAR;
#undef PG8_SA
#undef PG8_SB
#undef PG8_STAGE
#undef PG8_LDA
#undef PG8_LDB
#undef PG8_MMA
#undef PG8_WAIT_V
#undef PG8_WAIT_L
#undef PG8_BAR
#undef PG8_SCHED
}

typedef int v8i __attribute__((ext_vector_type(8)));
typedef int v4i __attribute__((ext_vector_type(4)));
__device__ __forceinline__ v8i cat8(v4i lo, v4i hi) { return __builtin_shufflevector(lo, hi, 0, 1, 2, 3, 4, 5, 6, 7); }
__device__ __forceinline__ bf16x8 lo8(v8i v) { return __builtin_bit_cast(bf16x8, (v4i)__builtin_shufflevector(v, v, 0, 1, 2, 3)); }
__device__ __forceinline__ bf16x8 hi8(v8i v) { return __builtin_bit_cast(bf16x8, (v4i)__builtin_shufflevector(v, v, 4, 5, 6, 7)); }
template <class Epi, class Sched, int MIXN8 = 0>
__device__ __forceinline__ void gemm_phase_fp8(PG8_LAS unsigned char* lds, const Gemm g, const Sched& S, const Epi& E) {
    int tid_ = threadIdx.x; asm volatile("" : "+v"(tid_));
    const int tid = tid_, wid = __builtin_amdgcn_readfirstlane(tid >> 6), lane = tid & 63, wr = wid >> 2, wc = wid & 3, fr = lane & 15, fq = lane >> 4;
    const int K = g.K, nt = K / 128;
    const __amdgpu_buffer_rsrc_t rA = __builtin_amdgcn_make_buffer_rsrc((void*)g.A, 0, g.M * K, 0x00020000), rB = __builtin_amdgcn_make_buffer_rsrc((void*)g.Bt, 0, g.N * K, 0x00020000);
    int voffA[2], voffB[2];
#pragma unroll
    for (int i = 0; i < 2; ++i) { int R, C; stage_rc(tid * 16 + i * 8192, R, C); const int Rb = Epi::PERM ? ((R & ~31) + perm32(R & 31)) : R;
        voffA[i] = R * K + C * 2; voffB[i] = Rb * K + C * 2; }
    const int kstep = 128, hstep = HALF * K, tstep = 2 * hstep;
    const unsigned ldsw = (unsigned)wid * 1024u;
    const int aoff = lds_byte(wr * 64 + fr, fq * 8), boff = lds_byte(wc * 32 + fr, fq * 8);
#define PG8_SA(b, h) (((b) * 2 + (h)) * HTB)
#define PG8_SB(b, h) ((4 + (b) * 2 + (h)) * HTB)
#define PG8_STAGE(bufoff, rsrc, soff, voff) do { _Pragma("unroll") for (int _i = 0; _i < 2; ++_i) \
        __builtin_amdgcn_raw_ptr_buffer_load_lds(rsrc, (PG8_LAS unsigned*)(lds + (bufoff) + ldsw + _i * 8192), 16, (voff)[_i], (soff), 0, 0); } while (0)
#define PG8_LDA(dst, b, h) do { _Pragma("unroll") for (int m = 0; m < 4; ++m) dst[m] = cat8(*(const PG8_LAS v4i*)(lds + PG8_SA(b, h) + aoff + m * 2048), *(const PG8_LAS v4i*)(lds + PG8_SA(b, h) + aoff + m * 2048 + 1024)); } while (0)
#define PG8_LDB(dst, b, h) do { _Pragma("unroll") for (int n = 0; n < 2; ++n) dst[n] = cat8(*(const PG8_LAS v4i*)(lds + PG8_SB(b, h) + boff + n * 2048), *(const PG8_LAS v4i*)(lds + PG8_SB(b, h) + boff + n * 2048 + 1024)); } while (0)
#define PG8_MMA8(ai, bj, At, Bt) do { __builtin_amdgcn_s_setprio(1); _Pragma("unroll") for (int m = 0; m < 4; ++m) _Pragma("unroll") for (int n = 0; n < 2; ++n) \
        acc[ai][bj][m][n] = __builtin_amdgcn_mfma_scale_f32_16x16x128_f8f6f4(Bt[n], At[m], acc[ai][bj][m][n], 0, 0, 0, 0x7f7f7f7f, 0, 0x7f7f7f7f); __builtin_amdgcn_s_setprio(0); } while (0)
#define PG8_MMA16(ai, bj, At, Bt) do { __builtin_amdgcn_s_setprio(1); _Pragma("unroll") for (int m = 0; m < 4; ++m) _Pragma("unroll") for (int n = 0; n < 2; ++n) { \
        acc[ai][bj][m][n] = __builtin_amdgcn_mfma_f32_16x16x32_bf16(lo8(Bt[n]), lo8(At[m]), acc[ai][bj][m][n], 0, 0, 0); \
        acc[ai][bj][m][n] = __builtin_amdgcn_mfma_f32_16x16x32_bf16(hi8(Bt[n]), hi8(At[m]), acc[ai][bj][m][n], 0, 0, 0); } __builtin_amdgcn_s_setprio(0); } while (0)
#define PG8_WAIT_V(n) asm volatile("s_waitcnt vmcnt(" #n ")" ::: "memory")
#define PG8_WAIT_L(n) asm volatile("s_waitcnt lgkmcnt(" #n ")" ::: "memory")
#define PG8_BAR __builtin_amdgcn_s_barrier()
#define PG8_SCHED __builtin_amdgcn_sched_barrier(0)
    Unit cur, nxt; int ui = 0;
    if (!S.next(0, cur)) return;
    f32x4 acc[2][2][4][2];
#pragma unroll
    for (int a = 0; a < 2; ++a)
#pragma unroll
        for (int b = 0; b < 2; ++b)
#pragma unroll
            for (int m = 0; m < 4; ++m)
#pragma unroll
                for (int n = 0; n < 2; ++n) acc[a][b][m][n] = (f32x4){0.f, 0.f, 0.f, 0.f};
    v8i At[4], B0[2], B1[2];
    int cA = cur.pm * tstep, cB = cur.pn * tstep;
    PG8_STAGE(PG8_SB(0, 0), rB, cB, voffB); PG8_STAGE(PG8_SB(0, 1), rB, cB + hstep, voffB); PG8_STAGE(PG8_SA(0, 0), rA, cA, voffA); PG8_STAGE(PG8_SA(0, 1), rA, cA + hstep, voffA);
    if (wr == 1) PG8_BAR;
    PG8_WAIT_V(2); PG8_BAR;
    PG8_STAGE(PG8_SB(1, 0), rB, cB + kstep, voffB); PG8_STAGE(PG8_SA(1, 0), rA, cA + kstep, voffA); PG8_STAGE(PG8_SB(1, 1), rB, cB + hstep + kstep, voffB);
    PG8_WAIT_V(6); PG8_BAR;
    for (;;) {
        const bool has_next = S.next(ui + 1, nxt);
        const int nA = has_next ? nxt.pm * tstep : cA, nB = has_next ? nxt.pn * tstep : cB;
#define PG8_KBODY(MM) { \
            const bool last = (t == nt - 2); \
            const int a1 = cA + (t + 1) * kstep; \
            const int a2 = last ? nA : cA + (t + 2) * kstep, b2 = last ? nB : cB + (t + 2) * kstep; \
            const int a3 = a2 + kstep, b3 = b2 + kstep; \
            PG8_LDB(B0, 0, 0); PG8_LDB(B1, 0, 1); PG8_SCHED; PG8_LDA(At, 0, 0); PG8_STAGE(PG8_SA(1, 1), rA, a1 + hstep, voffA); \
            PG8_WAIT_V(8); PG8_WAIT_L(0); PG8_BAR; MM(0, 0, At, B0); MM(0, 1, At, B1); PG8_BAR; PG8_SCHED; \
            PG8_LDA(At, 0, 1); PG8_STAGE(PG8_SB(0, 0), rB, b2, voffB); PG8_STAGE(PG8_SB(0, 1), rB, b2 + hstep, voffB); PG8_STAGE(PG8_SA(0, 0), rA, a2, voffA); \
            PG8_WAIT_V(8); PG8_WAIT_L(0); PG8_BAR; MM(1, 0, At, B0); MM(1, 1, At, B1); PG8_BAR; PG8_SCHED; \
            PG8_LDB(B0, 1, 0); PG8_LDB(B1, 1, 1); PG8_SCHED; PG8_LDA(At, 1, 0); PG8_STAGE(PG8_SA(0, 1), rA, a2 + hstep, voffA); \
            PG8_WAIT_V(8); PG8_WAIT_L(0); PG8_BAR; MM(0, 0, At, B0); MM(0, 1, At, B1); PG8_BAR; PG8_SCHED; \
            PG8_LDA(At, 1, 1); PG8_STAGE(PG8_SB(1, 0), rB, b3, voffB); PG8_STAGE(PG8_SB(1, 1), rB, b3 + hstep, voffB); PG8_STAGE(PG8_SA(1, 0), rA, a3, voffA); \
            PG8_WAIT_V(8); PG8_WAIT_L(0); PG8_BAR; MM(1, 0, At, B0); MM(1, 1, At, B1); PG8_BAR; PG8_SCHED; }
        if constexpr (MIXN8 > 0) {
            for (int t = 0; t < MIXN8; t += 2) PG8_KBODY(PG8_MMA8)
            for (int t = MIXN8; t < nt; t += 2) PG8_KBODY(PG8_MMA16)
        } else {
            for (int t = 0; t < nt; t += 2) PG8_KBODY(PG8_MMA8)
        }
#undef PG8_KBODY
        if (wr == 0) PG8_BAR;
        E(acc, cur, wr, wc, fr, fq);
        if (!has_next) break;
#pragma unroll
        for (int a = 0; a < 2; ++a)
#pragma unroll
            for (int b = 0; b < 2; ++b)
#pragma unroll
                for (int m = 0; m < 4; ++m)
#pragma unroll
                    for (int n = 0; n < 2; ++n) acc[a][b][m][n] = (f32x4){0.f, 0.f, 0.f, 0.f};
        cur = nxt; cA = nA; cB = nB; ++ui;
        if (wr == 1) PG8_BAR;
    }
    PG8_WAIT_V(0);
    PG8_BAR;
#undef PG8_SA
#undef PG8_SB
#undef PG8_STAGE
#undef PG8_LDA
#undef PG8_LDB
#undef PG8_MMA8
#undef PG8_MMA16
#undef PG8_WAIT_V
#undef PG8_WAIT_L
#undef PG8_BAR
#undef PG8_SCHED
}

template <class Epi, class Sched>
__device__ __forceinline__ void gemm_phase_i8(PG8_LAS unsigned char* lds, const Gemm g, const Sched& S, const Epi& E) {
    int tid_ = threadIdx.x; asm volatile("" : "+v"(tid_));
    const int tid = tid_, wid = __builtin_amdgcn_readfirstlane(tid >> 6), lane = tid & 63, wr = wid >> 2, wc = wid & 3, fr = lane & 15, fq = lane >> 4;
    const int K = g.K, nt = K / 128;
    const __amdgpu_buffer_rsrc_t rA = __builtin_amdgcn_make_buffer_rsrc((void*)g.A, 0, g.M * K, 0x00020000), rB = __builtin_amdgcn_make_buffer_rsrc((void*)g.Bt, 0, g.N * K, 0x00020000);
    int voffA[2], voffB[2];
#pragma unroll
    for (int i = 0; i < 2; ++i) { int R, C; stage_rc(tid * 16 + i * 8192, R, C); const int Rb = Epi::PERM ? ((R & ~31) + perm32(R & 31)) : R;
        voffA[i] = R * K + C * 2; voffB[i] = Rb * K + C * 2; }
    const int kstep = 128, hstep = HALF * K, tstep = 2 * hstep;
    const unsigned ldsw = (unsigned)wid * 1024u;
    const int aoff = lds_byte(wr * 64 + fr, fq * 8), boff = lds_byte(wc * 32 + fr, fq * 8);
#define PG8_SA(b, h) (((b) * 2 + (h)) * HTB)
#define PG8_SB(b, h) ((4 + (b) * 2 + (h)) * HTB)
#define PG8_STAGE(bufoff, rsrc, soff, voff) do { _Pragma("unroll") for (int _i = 0; _i < 2; ++_i) \
        __builtin_amdgcn_raw_ptr_buffer_load_lds(rsrc, (PG8_LAS unsigned*)(lds + (bufoff) + ldsw + _i * 8192), 16, (voff)[_i], (soff), 0, 0); } while (0)
#define PG8_LDA(dst, b, h) do { _Pragma("unroll") for (int m = 0; m < 4; ++m) dst[m] = cat8(*(const PG8_LAS v4i*)(lds + PG8_SA(b, h) + aoff + m * 2048), *(const PG8_LAS v4i*)(lds + PG8_SA(b, h) + aoff + m * 2048 + 1024)); } while (0)
#define PG8_LDB(dst, b, h) do { _Pragma("unroll") for (int n = 0; n < 2; ++n) dst[n] = cat8(*(const PG8_LAS v4i*)(lds + PG8_SB(b, h) + boff + n * 2048), *(const PG8_LAS v4i*)(lds + PG8_SB(b, h) + boff + n * 2048 + 1024)); } while (0)
#define PG8_MMA8(ai, bj, At, Bt) do { __builtin_amdgcn_s_setprio(1); _Pragma("unroll") for (int m = 0; m < 4; ++m) _Pragma("unroll") for (int n = 0; n < 2; ++n) { \
        acc[ai][bj][m][n] = __builtin_amdgcn_mfma_i32_16x16x64_i8((v4i)__builtin_shufflevector(Bt[n], Bt[n], 0, 1, 2, 3), (v4i)__builtin_shufflevector(At[m], At[m], 0, 1, 2, 3), acc[ai][bj][m][n], 0, 0, 0); \
        acc[ai][bj][m][n] = __builtin_amdgcn_mfma_i32_16x16x64_i8((v4i)__builtin_shufflevector(Bt[n], Bt[n], 4, 5, 6, 7), (v4i)__builtin_shufflevector(At[m], At[m], 4, 5, 6, 7), acc[ai][bj][m][n], 0, 0, 0); } __builtin_amdgcn_s_setprio(0); } while (0)
#define PG8_WAIT_V(n) asm volatile("s_waitcnt vmcnt(" #n ")" ::: "memory")
#define PG8_WAIT_L(n) asm volatile("s_waitcnt lgkmcnt(" #n ")" ::: "memory")
#define PG8_BAR __builtin_amdgcn_s_barrier()
#define PG8_SCHED __builtin_amdgcn_sched_barrier(0)
    Unit cur, nxt; int ui = 0;
    if (!S.next(0, cur)) return;
    v4i acc[2][2][4][2];
#pragma unroll
    for (int a = 0; a < 2; ++a)
#pragma unroll
        for (int b = 0; b < 2; ++b)
#pragma unroll
            for (int m = 0; m < 4; ++m)
#pragma unroll
                for (int n = 0; n < 2; ++n) acc[a][b][m][n] = (v4i){0, 0, 0, 0};
    v8i At[4], B0[2], B1[2];
    int cA = cur.pm * tstep, cB = cur.pn * tstep;
    PG8_STAGE(PG8_SB(0, 0), rB, cB, voffB); PG8_STAGE(PG8_SB(0, 1), rB, cB + hstep, voffB); PG8_STAGE(PG8_SA(0, 0), rA, cA, voffA); PG8_STAGE(PG8_SA(0, 1), rA, cA + hstep, voffA);
    if (wr == 1) PG8_BAR;
    PG8_WAIT_V(2); PG8_BAR;
    PG8_STAGE(PG8_SB(1, 0), rB, cB + kstep, voffB); PG8_STAGE(PG8_SA(1, 0), rA, cA + kstep, voffA); PG8_STAGE(PG8_SB(1, 1), rB, cB + hstep + kstep, voffB);
    PG8_WAIT_V(6); PG8_BAR;
    for (;;) {
        const bool has_next = S.next(ui + 1, nxt);
        const int nA = has_next ? nxt.pm * tstep : cA, nB = has_next ? nxt.pn * tstep : cB;
        const typename Epi::Pre pre = E.pre(cur, wr, wc, fr, fq);
#define PG8_KBODY(MM) { \
            const bool last = (t == nt - 2); \
            const int a1 = cA + (t + 1) * kstep; \
            const int a2 = last ? nA : cA + (t + 2) * kstep, b2 = last ? nB : cB + (t + 2) * kstep; \
            const int a3 = a2 + kstep, b3 = b2 + kstep; \
            PG8_LDB(B0, 0, 0); PG8_LDB(B1, 0, 1); PG8_SCHED; PG8_LDA(At, 0, 0); PG8_STAGE(PG8_SA(1, 1), rA, a1 + hstep, voffA); \
            PG8_WAIT_V(8); PG8_WAIT_L(0); PG8_BAR; MM(0, 0, At, B0); MM(0, 1, At, B1); PG8_BAR; PG8_SCHED; \
            PG8_LDA(At, 0, 1); PG8_STAGE(PG8_SB(0, 0), rB, b2, voffB); PG8_STAGE(PG8_SB(0, 1), rB, b2 + hstep, voffB); PG8_STAGE(PG8_SA(0, 0), rA, a2, voffA); \
            PG8_WAIT_V(8); PG8_WAIT_L(0); PG8_BAR; MM(1, 0, At, B0); MM(1, 1, At, B1); PG8_BAR; PG8_SCHED; \
            PG8_LDB(B0, 1, 0); PG8_LDB(B1, 1, 1); PG8_SCHED; PG8_LDA(At, 1, 0); PG8_STAGE(PG8_SA(0, 1), rA, a2 + hstep, voffA); \
            PG8_WAIT_V(8); PG8_WAIT_L(0); PG8_BAR; MM(0, 0, At, B0); MM(0, 1, At, B1); PG8_BAR; PG8_SCHED; \
            PG8_LDA(At, 1, 1); PG8_STAGE(PG8_SB(1, 0), rB, b3, voffB); PG8_STAGE(PG8_SB(1, 1), rB, b3 + hstep, voffB); PG8_STAGE(PG8_SA(1, 0), rA, a3, voffA); \
            PG8_WAIT_V(8); PG8_WAIT_L(0); PG8_BAR; MM(1, 0, At, B0); MM(1, 1, At, B1); PG8_BAR; PG8_SCHED; }
        for (int t = 0; t < nt; t += 2) PG8_KBODY(PG8_MMA8)
#undef PG8_KBODY
        if (wr == 0) PG8_BAR;
        E(acc, cur, wr, wc, fr, fq, pre);
        if (!has_next) break;
#pragma unroll
        for (int a = 0; a < 2; ++a)
#pragma unroll
            for (int b = 0; b < 2; ++b)
#pragma unroll
                for (int m = 0; m < 4; ++m)
#pragma unroll
                    for (int n = 0; n < 2; ++n) acc[a][b][m][n] = (v4i){0, 0, 0, 0};
        cur = nxt; cA = nA; cB = nB; ++ui;
        if (wr == 1) PG8_BAR;
    }
    PG8_WAIT_V(0);
    PG8_BAR;
#undef PG8_SA
#undef PG8_SB
#undef PG8_STAGE
#undef PG8_LDA
#undef PG8_LDB
#undef PG8_MMA8
#undef PG8_WAIT_V
#undef PG8_WAIT_L
#undef PG8_BAR
#undef PG8_SCHED
}
}

constexpr int NB = 4, SEQ = 4096, DM = 4096, NH = 16, HD = 128, DA = 2048, DR = 2048, DIN = 10240, DFF = 11008, NGU = 2 * DFF, PLE = 256;
constexpr int M = NB * SEQ;
constexpr int COL_Q = 0, COL_K = 2048, COL_V = 4096, COL_XR = 6144, COL_GR = 8192;
constexpr float NORM_EPS = 1e-6f;
constexpr float QSCALE = 0.08838834764831845f * 1.4426950408889634f;
constexpr int DN8 = 30, DK1 = DN8 * 128, DK2 = DFF - DK1, DPITCH = DK1 + 2 * DK2;
constexpr float HID_SCALE = 16.0f, WDN_SCALE = 64.0f;
constexpr float C2_EXIT = 152.0f;

constexpr size_t MiB = 1u << 20;
constexpr int NI8 = 2 * DA;
constexpr size_t WS_CTL = 0;
constexpr size_t WS_WIN = 1 * MiB, WS_WOUT = 81 * MiB, WS_WGU = 113 * MiB, WS_WDN = 285 * MiB, WS_WPG = 371 * MiB, WS_WPP = 403 * MiB, WS_WRA = 405 * MiB, WS_WRX = WS_WRA + MiB / 2;
constexpr size_t WS_PB = 406 * MiB;
constexpr size_t WS_A1 = 414 * MiB;
constexpr size_t WS_A2 = 542 * MiB;
constexpr size_t WS_HID = 414 * MiB;
constexpr size_t WS_HB = 758 * MiB;
constexpr size_t WS_SA = 64 * 1024;
constexpr size_t WS_SB = 768 * 1024;
constexpr size_t WS_SBIN = 896 * 1024;
constexpr size_t WS_RSXQ = 944 * 1024;
constexpr size_t WS_RSX = 384 * 1024;
constexpr size_t WS_SS1 = 128 * 1024, WS_SS2 = 256 * 1024;
constexpr size_t WS_PE = 886 * MiB;
constexpr size_t WS_HB8 = 1014 * MiB;
constexpr size_t WS_END = 1078 * MiB;
static_assert(WS_WIN + (size_t)DIN * DM * 2 <= WS_WOUT && WS_WOUT + (size_t)DM * DM * 2 <= WS_WGU && WS_WGU + (size_t)NGU * DM * 2 <= WS_WDN && WS_WDN + (size_t)DM * DFF * 2 <= WS_WPG && WS_WPG + (size_t)DM * DM * 2 <= WS_WPP && WS_WPP + (size_t)DM * PLE * 2 <= WS_WRA, "ws map: weights");
static_assert(WS_PB + (size_t)M * PLE * 2 <= WS_A1 && WS_A1 + (size_t)M * DM * 2 <= WS_A2 && WS_A2 + (size_t)M * DIN * 2 <= WS_PE && WS_HID + (size_t)M * DPITCH <= WS_HB && DPITCH % 128 == 0 && (DPITCH / 128 - DN8) % 2 == 0 && DN8 % 2 == 0 && WS_HB + (size_t)M * DM * 2 <= WS_PE && WS_PE + (size_t)M * DM * 2 <= WS_END, "ws map: activations");

constexpr int NWAVES = 8;
constexpr int LDS_BYTES = 147456;

#define GAS __attribute__((address_space(1)))
#define LAS __attribute__((address_space(3)))
typedef unsigned short bf16;
typedef unsigned v4u __attribute__((ext_vector_type(4)));
typedef unsigned v2u __attribute__((ext_vector_type(2)));
typedef float f32x4 __attribute__((ext_vector_type(4)));
typedef float f32x2 __attribute__((ext_vector_type(2)));
#define LDS_WAIT() asm volatile("s_waitcnt lgkmcnt(0)" ::: "memory")
__device__ __forceinline__ unsigned f2bf(float f) { unsigned u = __builtin_bit_cast(unsigned, f); return (u + 0x7fffu + ((u >> 16) & 1u)) >> 16; }
__device__ __forceinline__ unsigned pk2(float lo, float hi) { unsigned r; asm("v_cvt_pk_bf16_f32 %0, %1, %2" : "=v"(r) : "v"(lo), "v"(hi)); return r; }
__device__ __forceinline__ float bf_lo(unsigned w) { return __uint_as_float(w << 16); }
__device__ __forceinline__ float bf_hi(unsigned w) { return __uint_as_float(w & 0xffff0000u); }
using pg8::sxf; using pg8::sxu; using pg8::sum32; using pg8::max32;
__device__ __forceinline__ float wave_sum(float v) {
    v += sxf<1>(v); v += sxf<2>(v); v += sxf<4>(v); v += sxf<8>(v); v += sxf<16>(v);
    return sum32(v);
}

struct TrItem { const float* src; bf16* dst; const float* gain; int N, K, keep; float scale; };
__device__ __forceinline__ TrItem tr_make(const float* W, int K, int N, bf16* WT, int mode, const float* gain, int item) {
    const int nblk = N / 64, kb = item / nblk, nb = item % nblk, k0 = 64 * kb, n0 = 64 * nb;
    int drow0 = n0;
    if (mode == 1) drow0 = (n0 >> 7) * 256 + (n0 & 127);
    if (mode == 2) drow0 = (n0 >> 7) * 256 + 128 + (n0 & 127);
    TrItem t; t.src = W + (size_t)k0 * N + n0; t.dst = WT + (size_t)drow0 * K + k0; t.gain = gain ? gain + k0 : nullptr; t.N = N; t.K = K; t.keep = 0; t.scale = 1.0f; return t;
}
__device__ __forceinline__ void tr_load(const TrItem& t, f32x4 (&v)[16], int lane) {
    const int q = lane >> 4, c = lane & 15;
    const float* src = t.src + (size_t)(2 * q) * t.N + 4 * c;
#pragma unroll
    for (int i = 0; i < 16; ++i) v[i] = __builtin_nontemporal_load((const f32x4*)(src + (size_t)(8 * (i >> 1) + (i & 1)) * t.N));
}
__device__ __forceinline__ void tr_process(const TrItem& t, const f32x4 (&v)[16], LAS unsigned* scr, int lane) {
    const int q = lane >> 4, c = lane & 15;
    f32x2 gk[8];
#pragma unroll
    for (int j = 0; j < 8; ++j) gk[j] = (t.gain ? *(const f32x2*)(t.gain + 8 * j + 2 * q) : (f32x2){1.f, 1.f}) * t.scale;
#pragma unroll
    for (int j = 0; j < 8; ++j) { LAS unsigned* d = scr + (4 * j + q) * 65 + 4 * c;
        d[0] = pk2(v[2 * j].x * gk[j].x, v[2 * j + 1].x * gk[j].y); d[1] = pk2(v[2 * j].y * gk[j].x, v[2 * j + 1].y * gk[j].y);
        d[2] = pk2(v[2 * j].z * gk[j].x, v[2 * j + 1].z * gk[j].y); d[3] = pk2(v[2 * j].w * gk[j].x, v[2 * j + 1].w * gk[j].y); }
    LDS_WAIT(); asm volatile("" ::: "memory");
    const int a8 = lane & 7, b8 = lane >> 3;
#pragma unroll
    for (int m = 0; m < 8; ++m) { const int n = b8 + 8 * m; const LAS unsigned* s = scr + (4 * a8) * 65 + n;
        v4u o; o.x = s[0]; o.y = s[65]; o.z = s[130]; o.w = s[195];
        if (t.keep) *(v4u*)(t.dst + (size_t)n * t.K + 8 * a8) = o; else __builtin_nontemporal_store(o, (v4u*)(t.dst + (size_t)n * t.K + 8 * a8));
 }
    LDS_WAIT(); asm volatile("" ::: "memory");
}

__device__ __forceinline__ void tr8_load(const TrItem& t, f32x4 (&v)[16], int lane) {
    const int q = lane >> 4, c = lane & 15;
    const float* src = t.src + (size_t)(4 * q) * t.N + 4 * c;
#pragma unroll
    for (int i = 0; i < 16; ++i) v[i] = __builtin_nontemporal_load((const f32x4*)(src + (size_t)(16 * (i >> 2) + (i & 3)) * t.N));
}
__device__ __forceinline__ unsigned pk4_fp8(float a, float b, float c, float d) {
    int w = 0; w = __builtin_amdgcn_cvt_pk_fp8_f32(__builtin_amdgcn_fmed3f(a, -448.f, 448.f), __builtin_amdgcn_fmed3f(b, -448.f, 448.f), w, false);
    w = __builtin_amdgcn_cvt_pk_fp8_f32(__builtin_amdgcn_fmed3f(c, -448.f, 448.f), __builtin_amdgcn_fmed3f(d, -448.f, 448.f), w, true); return (unsigned)w;
}
__device__ __forceinline__ void tr8_process(const TrItem& t, const f32x4 (&v)[16], float scale, LAS unsigned* scr, int lane) {
    const int q = lane >> 4, c = lane & 15;
#pragma unroll
    for (int j = 0; j < 4; ++j) { f32x4 gk = t.gain ? *(const f32x4*)(t.gain + 16 * j + 4 * q) : (f32x4){1.f, 1.f, 1.f, 1.f}; gk = gk * scale;
        LAS unsigned* d = scr + (4 * j + q) * 65 + 4 * c;
        d[0] = pk4_fp8(v[4 * j].x * gk.x, v[4 * j + 1].x * gk.y, v[4 * j + 2].x * gk.z, v[4 * j + 3].x * gk.w);
        d[1] = pk4_fp8(v[4 * j].y * gk.x, v[4 * j + 1].y * gk.y, v[4 * j + 2].y * gk.z, v[4 * j + 3].y * gk.w);
        d[2] = pk4_fp8(v[4 * j].z * gk.x, v[4 * j + 1].z * gk.y, v[4 * j + 2].z * gk.z, v[4 * j + 3].z * gk.w);
        d[3] = pk4_fp8(v[4 * j].w * gk.x, v[4 * j + 1].w * gk.y, v[4 * j + 2].w * gk.z, v[4 * j + 3].w * gk.w); }
    LDS_WAIT(); asm volatile("" ::: "memory");
    const int a4 = lane & 3, b16 = lane >> 2;
#pragma unroll
    for (int m = 0; m < 4; ++m) { const int n = b16 + 16 * m; const LAS unsigned* s = scr + (4 * a4) * 65 + n;
        v4u o; o.x = s[0]; o.y = s[65]; o.z = s[130]; o.w = s[195];
        __builtin_nontemporal_store(o, (v4u*)((unsigned char*)t.dst + (size_t)n * t.K + 16 * a4)); }
    LDS_WAIT(); asm volatile("" ::: "memory");
}

__device__ __forceinline__ void row_load(const float* row, f32x4 (&v)[16], int lane) {
    const f32x4* xr = (const f32x4*)row + lane;
#pragma unroll
    for (int j = 0; j < 16; ++j) v[j] = __builtin_nontemporal_load(xr + 64 * j);
}
template <bool BF> __device__ __forceinline__ void row_finish(const f32x4 (&v)[16], const float* g, void* dstrow, int lane) {
    float s = 0.f;
#pragma unroll
    for (int j = 0; j < 16; ++j) s += (v[j].x * v[j].x + v[j].y * v[j].y) + (v[j].z * v[j].z + v[j].w * v[j].w);
    const float rstd = 1.0f / sqrtf(wave_sum(s) * (1.f / DM) + NORM_EPS);
    const f32x4* gr = (const f32x4*)g + lane;
    if (BF) { v2u* o8 = (v2u*)dstrow + lane;
#pragma unroll
        for (int j = 0; j < 16; ++j) { const f32x4 gg = gr[64 * j]; v2u w; w.x = pk2(v[j].x * rstd * gg.x, v[j].y * rstd * gg.y); w.y = pk2(v[j].z * rstd * gg.z, v[j].w * rstd * gg.w); o8[64 * j] = w; }
    } else { f32x4* o = (f32x4*)dstrow + lane;
#pragma unroll
        for (int j = 0; j < 16; ++j) { const f32x4 gg = gr[64 * j]; o[64 * j] = (f32x4){v[j].x * rstd * gg.x, v[j].y * rstd * gg.y, v[j].z * rstd * gg.z, v[j].w * rstd * gg.w}; } }
}
__device__ __forceinline__ unsigned q4_i8(float a, float b, float c, float d) {
    const int ia = (int)__builtin_rintf(a), ib = (int)__builtin_rintf(b), ic = (int)__builtin_rintf(c), id = (int)__builtin_rintf(d);
    return (unsigned)(ia & 255) | ((unsigned)(ib & 255) << 8) | ((unsigned)(ic & 255) << 16) | ((unsigned)id << 24);
}
__device__ __forceinline__ void row_cast_finish(const f32x4 (&v)[16], bf16* dstrow, signed char* q8row, float* rstd_out, int lane) {
    float s = 0.f, mx = 0.f;
#pragma unroll
    for (int j = 0; j < 16; ++j) { s += (v[j].x * v[j].x + v[j].y * v[j].y) + (v[j].z * v[j].z + v[j].w * v[j].w);
        mx = fmaxf(mx, fmaxf(fmaxf(fabsf(v[j].x), fabsf(v[j].y)), fmaxf(fabsf(v[j].z), fabsf(v[j].w)))); }
    const float rstd = 1.0f / sqrtf(wave_sum(s) * (1.f / DM) + NORM_EPS);
    mx = fmaxf(mx, sxf<1>(mx)); mx = fmaxf(mx, sxf<2>(mx)); mx = fmaxf(mx, sxf<4>(mx)); mx = fmaxf(mx, sxf<8>(mx)); mx = fmaxf(mx, sxf<16>(mx)); mx = max32(mx);
    const float inv = mx > 0.f ? 127.0f / mx : 0.f;
    if (lane == 0) { rstd_out[0] = rstd; rstd_out[(WS_RSXQ - WS_RSX) / 4] = rstd * (mx * (1.0f / 127.0f)); }
    { unsigned* o1 = (unsigned*)q8row + lane;
#pragma unroll
      for (int j = 0; j < 16; ++j) o1[64 * j] = q4_i8(v[j].x * inv, v[j].y * inv, v[j].z * inv, v[j].w * inv); }
    v2u* o8 = (v2u*)dstrow + lane;
#pragma unroll
    for (int j = 0; j < 16; ++j) { v2u w; w.x = pk2(v[j].x, v[j].y); w.y = pk2(v[j].z, v[j].w); o8[64 * j] = w; }
}
__device__ __forceinline__ void cast_rows(const float* src, bf16* dst, signed char* q8, float* rsx, int gw, int NGW, int lane) {
    int m = gw; if (m >= M) return;
    f32x4 va[16], vb[16];
    row_load(src + (size_t)m * DM, va, lane);
    for (;;) {
        { const int mn = m + NGW; const bool has = mn < M; row_load(src + (size_t)(has ? mn : m) * DM, vb, lane);
          row_cast_finish(va, dst + (size_t)m * DM, q8 + (size_t)m * DM, rsx + m, lane); if (!has) break; m = mn; }
        { const int mn = m + NGW; const bool has = mn < M; row_load(src + (size_t)(has ? mn : m) * DM, va, lane);
          row_cast_finish(vb, dst + (size_t)m * DM, q8 + (size_t)m * DM, rsx + m, lane); if (!has) break; m = mn; }
    }
}
template <bool BF> __device__ __forceinline__ void rms_rows(const float* src, const float* g, void* dst, int gw, int NGW, int lane) {
    int m = gw; if (m >= M) return;
    f32x4 va[16], vb[16];
    const size_t dpitch = BF ? (size_t)DM * 2 : (size_t)DM * 4;
    row_load(src + (size_t)m * DM, va, lane);
    for (;;) {
        { const int mn = m + NGW; const bool has = mn < M; row_load(src + (size_t)(has ? mn : m) * DM, vb, lane);
          row_finish<BF>(va, g, (char*)dst + (size_t)m * dpitch, lane); if (!has) break; m = mn; }
        { const int mn = m + NGW; const bool has = mn < M; row_load(src + (size_t)(has ? mn : m) * DM, va, lane);
          row_finish<BF>(vb, g, (char*)dst + (size_t)m * dpitch, lane); if (!has) break; m = mn; }
    }
}
__device__ __forceinline__ void rowb_load(const bf16* row, v4u (&v)[8], int lane) {
    const v4u* xr = (const v4u*)row + lane;
#pragma unroll
    for (int j = 0; j < 8; ++j) v[j] = __builtin_nontemporal_load(xr + 64 * j);
}
__device__ __forceinline__ void rowb_finish(const v4u (&w)[8], const float* g, float* dstrow, int lane) {
    float s = 0.f;
#pragma unroll
    for (int j = 0; j < 8; ++j)
#pragma unroll
        for (int e = 0; e < 4; ++e) { const float a = bf_lo(w[j][e]), b = bf_hi(w[j][e]); s += a * a + b * b; }
    const float rstd = 1.0f / sqrtf(wave_sum(s) * (1.f / DM) + NORM_EPS);
#pragma unroll
    for (int j = 0; j < 8; ++j) { const f32x4* gp = (const f32x4*)(g + (64 * j + lane) * 8); const f32x4 g0 = gp[0], g1 = gp[1]; f32x4* o = (f32x4*)(dstrow + (64 * j + lane) * 8);
        __builtin_nontemporal_store((f32x4){bf_lo(w[j].x) * rstd * g0.x, bf_hi(w[j].x) * rstd * g0.y, bf_lo(w[j].y) * rstd * g0.z, bf_hi(w[j].y) * rstd * g0.w}, o);
        __builtin_nontemporal_store((f32x4){bf_lo(w[j].z) * rstd * g1.x, bf_hi(w[j].z) * rstd * g1.y, bf_lo(w[j].w) * rstd * g1.z, bf_hi(w[j].w) * rstd * g1.w}, o + 1); }
}
__device__ __forceinline__ void rms_rows_b2f(const bf16* src, const float* g, float* dst, int gw, int NGW, int lane) {
    int m = gw; if (m >= M) return;
    v4u va[8], vb[8];
    rowb_load(src + (size_t)m * DM, va, lane);
    for (;;) {
        { const int mn = m + NGW; const bool has = mn < M; rowb_load(src + (size_t)(has ? mn : m) * DM, vb, lane);
          rowb_finish(va, g, dst + (size_t)m * DM, lane); if (!has) break; m = mn; }
        { const int mn = m + NGW; const bool has = mn < M; rowb_load(src + (size_t)(has ? mn : m) * DM, va, lane);
          rowb_finish(vb, g, dst + (size_t)m * DM, lane); if (!has) break; m = mn; }
    }
}
template <bool RSTD = false>
__device__ __forceinline__ void quant_rows_i8(const bf16* src, signed char* dst, float* scale, int nrows, int gw, int NGW, int lane) {
    for (int r = gw; r < nrows; r += NGW) {
        const v4u* p = (const v4u*)(src + (size_t)r * 4096) + lane; v4u w[8];
#pragma unroll
        for (int j = 0; j < 8; ++j) w[j] = __builtin_nontemporal_load(p + 64 * j);
        unsigned mb = 0u;
#pragma unroll
        for (int j = 0; j < 8; ++j)
#pragma unroll
            for (int e = 0; e < 4; ++e) { const unsigned lo_ = (w[j][e] << 16) & 0x7fff0000u, hi_ = w[j][e] & 0x7fff0000u; mb = mb > lo_ ? mb : lo_; mb = mb > hi_ ? mb : hi_; }
        float mx = __uint_as_float(mb);
        mx = fmaxf(mx, sxf<1>(mx)); mx = fmaxf(mx, sxf<2>(mx)); mx = fmaxf(mx, sxf<4>(mx)); mx = fmaxf(mx, sxf<8>(mx)); mx = fmaxf(mx, sxf<16>(mx)); mx = max32(mx);
        const float inv = mx > 0.f ? 127.0f / mx : 0.f;
        float rstd = 1.0f;
        if constexpr (RSTD) { float sq = 0.f;
#pragma unroll
            for (int j = 0; j < 8; ++j)
#pragma unroll
                for (int e = 0; e < 4; ++e) { const float a = bf_lo(w[j][e]), b = bf_hi(w[j][e]); sq += a * a + b * b; }
            rstd = __builtin_amdgcn_rsqf(wave_sum(sq) * (1.0f / 4096.0f) + NORM_EPS); }
        if (lane == 0) scale[r] = rstd * (mx * (1.0f / 127.0f));
        v2u* o = (v2u*)(dst + (size_t)r * 4096) + lane;
#pragma unroll
        for (int j = 0; j < 8; ++j) { v2u q; q.x = q4_i8(bf_lo(w[j].x) * inv, bf_hi(w[j].x) * inv, bf_lo(w[j].y) * inv, bf_hi(w[j].y) * inv); q.y = q4_i8(bf_lo(w[j].z) * inv, bf_hi(w[j].z) * inv, bf_lo(w[j].w) * inv, bf_hi(w[j].w) * inv); o[64 * j] = q; }
    }
}
__device__ __forceinline__ void rms_seg2048_bf16(bf16* seg, const float* g, int lane) {
    v4u* p = (v4u*)seg + lane; v4u w[4]; float s = 0.f;
#pragma unroll
    for (int j = 0; j < 4; ++j) { w[j] = p[64 * j];
#pragma unroll
        for (int e = 0; e < 4; ++e) { const float a = bf_lo(w[j][e]), b = bf_hi(w[j][e]); s += a * a + b * b; } }
    const float rstd = 1.0f / sqrtf(wave_sum(s) * (1.f / 2048.f) + NORM_EPS);
#pragma unroll
    for (int j = 0; j < 4; ++j) { const f32x4* gp = (const f32x4*)(g + (64 * j + lane) * 8); const f32x4 g0 = gp[0], g1 = gp[1]; v4u o;
        o.x = pk2(bf_lo(w[j].x) * rstd * g0.x, bf_hi(w[j].x) * rstd * g0.y); o.y = pk2(bf_lo(w[j].y) * rstd * g0.z, bf_hi(w[j].y) * rstd * g0.w);
        o.z = pk2(bf_lo(w[j].z) * rstd * g1.x, bf_hi(w[j].z) * rstd * g1.y); o.w = pk2(bf_lo(w[j].w) * rstd * g1.z, bf_hi(w[j].w) * rstd * g1.w);
        p[64 * j] = o; }
}
__device__ __forceinline__ void rms_row4096_bf16(bf16* row, const float* g, int lane) {
    v4u* p = (v4u*)row + lane; v4u w[8]; float s = 0.f;
#pragma unroll
    for (int j = 0; j < 8; ++j) { w[j] = p[64 * j];
#pragma unroll
        for (int e = 0; e < 4; ++e) { const float a = bf_lo(w[j][e]), b = bf_hi(w[j][e]); s += a * a + b * b; } }
    const float rstd = 1.0f / sqrtf(wave_sum(s) * (1.f / 4096.f) + NORM_EPS);
#pragma unroll
    for (int j = 0; j < 8; ++j) { const f32x4* gp = (const f32x4*)(g + (64 * j + lane) * 8); const f32x4 g0 = gp[0], g1 = gp[1]; v4u o;
        o.x = pk2(bf_lo(w[j].x) * rstd * g0.x, bf_hi(w[j].x) * rstd * g0.y); o.y = pk2(bf_lo(w[j].y) * rstd * g0.z, bf_hi(w[j].y) * rstd * g0.w);
        o.z = pk2(bf_lo(w[j].z) * rstd * g1.x, bf_hi(w[j].z) * rstd * g1.y); o.w = pk2(bf_lo(w[j].w) * rstd * g1.z, bf_hi(w[j].w) * rstd * g1.w);
        p[64 * j] = o; }
}

struct Args {
    const float *x, *p, *g_mix, *w_in, *conv_w, *conv_b, *w_rg_a, *b_rg_a, *w_rg_x, *b_rg_x, *rg_lambda, *g_attn_out, *g_rnn_out, *w_out, *g_ffn, *w_ffn_gate, *w_ffn_up, *w_ffn_down, *g_ple, *w_ple_gate, *w_ple_proj, *g_ple_out, *g_final;
    float* out; unsigned char* ws;
};

#define XB_TMO      128
#define XB_XCNT(j)  (256  + 64 * (j))
#define XB_XSUB(j)  (1280 + 64 * (j))
#define XB_XGEN(j)  (2304 + 64 * (j))
#define XB_TOP      3328
#define XB_TOPGEN   3392
#define XCD_BAR_WORDS 3456
#define XB_SPIN_CAP (1u << 18)

__device__ __forceinline__ unsigned xb_ld(unsigned* p)              { return __hip_atomic_load(p, __ATOMIC_RELAXED, __HIP_MEMORY_SCOPE_AGENT); }
__device__ __forceinline__ unsigned xb_add(unsigned* p, unsigned v) { return __hip_atomic_fetch_add(p, v, __ATOMIC_RELAXED, __HIP_MEMORY_SCOPE_AGENT); }
__device__ __forceinline__ unsigned xb_xcc_id() { return (unsigned)__builtin_amdgcn_s_getreg((3 << 11) | 20) & 0xFu; }
#define XB_SPIN(cond, bar) do { unsigned _sp = 0; while (cond) { __builtin_amdgcn_s_sleep(1); \
    if ((++_sp & 255u) == 0u) { if (xb_ld(&(bar)[XB_TMO])) break; if (_sp > XB_SPIN_CAP) { atomicAdd(&(bar)[XB_TMO], 1u); break; } } } } while (0)

struct XcdBarrier {
    unsigned* bar; unsigned x;
    volatile LAS unsigned* st;
};
__device__ __forceinline__ XcdBarrier xcd_barrier_post(unsigned* bar, volatile LAS unsigned* st) {
    XcdBarrier b; b.bar = bar; b.x = xb_xcc_id(); b.st = st;
    if (threadIdx.x == 0) (void)xb_add(&bar[XB_XCNT(b.x)], 1u);
    return b;
}
__device__ __forceinline__ void xcd_barrier_complete(unsigned* bar, unsigned x, unsigned& nloc, unsigned& nx) {
    const unsigned G = gridDim.x * gridDim.y * gridDim.z;
    unsigned sum, cnt, mine, sp = 0u;
    for (;;) {
        sum = 0u; cnt = 0u; mine = 0u;
#pragma unroll
        for (unsigned j = 0; j < 16; ++j) { const unsigned c = xb_ld(&bar[XB_XCNT(j)]); sum += c; cnt += (c > 0u) ? 1u : 0u; mine = (j == x) ? c : mine; }
        if (sum == G) break;
        __builtin_amdgcn_s_sleep(1);
        if ((++sp & 255u) == 0u) { if (xb_ld(&bar[XB_TMO])) break; if (sp > XB_SPIN_CAP) { atomicAdd(&bar[XB_TMO], 1u); break; } }
    }
    nloc = mine > 0u ? mine : 1u; nx = cnt > 0u ? cnt : 1u;
}
__device__ __forceinline__ void xcd_barrier(const XcdBarrier& b) {
    asm volatile("s_waitcnt vmcnt(0)" ::: "memory");
    __syncthreads();
    if (threadIdx.x == 0) {
        unsigned* bar = b.bar;
        __builtin_amdgcn_s_waitcnt(0);
        unsigned nloc = b.st[0], nx = b.st[1];
        if (nloc == 0u) { xcd_barrier_complete(bar, b.x, nloc, nx); b.st[0] = nloc; b.st[1] = nx; }
        const unsigned old = xb_add(&bar[XB_XSUB(b.x)], 1u);
        const unsigned gen = old / nloc;
        if (old + 1u == (gen + 1u) * nloc) {
            __builtin_amdgcn_fence(__ATOMIC_RELEASE, "agent");
            asm volatile("s_waitcnt vmcnt(0)" ::: "memory");
            const unsigned og = xb_add(&bar[XB_TOP], 1u);
            const unsigned tg = og / nx;
            if (og + 1u == (tg + 1u) * nx) xb_add(&bar[XB_TOPGEN], 1u);
            else XB_SPIN(xb_ld(&bar[XB_TOPGEN]) == tg, bar);
            __builtin_amdgcn_fence(__ATOMIC_ACQUIRE, "agent");
            xb_add(&bar[XB_XGEN(b.x)], 1u);
            asm volatile("s_waitcnt vmcnt(0)" ::: "memory");
        } else {
            XB_SPIN(xb_ld(&bar[XB_XGEN(b.x)]) == gen, bar);
            __builtin_amdgcn_fence(__ATOMIC_ACQUIRE, "agent");
            asm volatile("s_waitcnt vmcnt(0)" ::: "memory");
        }
    }
    __syncthreads();
}

namespace rg {
constexpr int RT = 128, NT = SEQ / RT;
constexpr int XCT_BYTES = RT * 256, GRT_BYTES = RT * 64;
constexpr int XCT_OFF = 0, GRT_OFF = 2 * XCT_BYTES, OUT_OFF = GRT_OFF + 2 * GRT_BYTES, SUM_OFF = OUT_OFF + RT * 64, LDS_END = SUM_OFF + 2 * 1024;
typedef short bf16x8 __attribute__((ext_vector_type(8)));
__device__ __forceinline__ float sigmoidf_fast(float x) { return __builtin_amdgcn_rcpf(1.0f + __builtin_amdgcn_exp2f(-1.4426950408889634f * x)); }

__device__ __forceinline__ void rglru_unit(const Args& a, const bf16* proj, bf16* mixed, float* part, const bf16* wra_t, const bf16* wrx_t, LAS unsigned char* lds, int unit) {
    int tid_ = threadIdx.x; asm volatile("" : "+v"(tid_));
    const int tid = tid_, lane = tid & 63, wave = __builtin_amdgcn_readfirstlane(tid >> 6), fr = lane & 15, fq = lane >> 4;
    const int cg = wave & 1, ts = wave >> 1;
    const int b = unit >> 6, n = (unit >> 2) & 15, cq = unit & 3;
    const int ch0 = n * 128, oc = cq * 32 + cg * 16 + fr, c = ch0 + oc;
    bf16x8 Ba[4], Bx[4];
#pragma unroll
    for (int ks = 0; ks < 4; ++ks) { Ba[ks] = *(const bf16x8*)(wra_t + (size_t)n * 16384 + oc * 128 + 32 * ks + 8 * fq); Bx[ks] = *(const bf16x8*)(wrx_t + (size_t)n * 16384 + oc * 128 + 32 * ks + 8 * fq); }
    const float b_a = a.b_rg_a[c], b_x = a.b_rg_x[c];
    const float cl = 8.0f * 1.4426950408889634f * log1pf(expf(-a.rg_lambda[c]));
    const int s_chunk = tid & 15, s_tg = tid >> 4;
    float cw[4][8], cb[8];
#pragma unroll
    for (int k = 0; k < 4; ++k) { const f32x4 w0 = *(const f32x4*)(a.conv_w + k * DR + ch0 + 8 * s_chunk), w1 = *(const f32x4*)(a.conv_w + k * DR + ch0 + 8 * s_chunk + 4);
        cw[k][0] = w0.x; cw[k][1] = w0.y; cw[k][2] = w0.z; cw[k][3] = w0.w; cw[k][4] = w1.x; cw[k][5] = w1.y; cw[k][6] = w1.z; cw[k][7] = w1.w; }
    { const f32x4 w0 = *(const f32x4*)(a.conv_b + ch0 + 8 * s_chunk), w1 = *(const f32x4*)(a.conv_b + ch0 + 8 * s_chunk + 4);
      cb[0] = w0.x; cb[1] = w0.y; cb[2] = w0.z; cb[3] = w0.w; cb[4] = w1.x; cb[5] = w1.y; cb[6] = w1.z; cb[7] = w1.w; }
    const bf16* xr_base = proj + (size_t)b * SEQ * DIN + COL_XR + ch0 + 8 * s_chunk;
    const bf16* gr_base = proj + (size_t)b * SEQ * DIN + COL_GR + ch0 + cq * 32 + 8 * (tid & 3);
    bf16* out_base = mixed + (size_t)b * SEQ * DM + DA + ch0 + cq * 32 + 8 * (tid & 3);
    v4u xr7[7], grv;
#define RG_LOAD(i) do { const int t0_ = (i) * RT + 4 * s_tg - 3; _Pragma("unroll") for (int k = 0; k < 7; ++k) { const int tt = t0_ + k; \
        xr7[k] = (tt >= 0) ? *(const v4u*)(xr_base + (size_t)tt * DIN) : (v4u){0u, 0u, 0u, 0u}; } \
        grv = *(const v4u*)(gr_base + (size_t)((i) * RT + (tid >> 2)) * DIN); } while (0)
#define RG_CONV_WRITE(buf) do { _Pragma("unroll") for (int j = 0; j < 4; ++j) { float o[8]; _Pragma("unroll") for (int e = 0; e < 8; ++e) o[e] = cb[e]; \
        _Pragma("unroll") for (int k = 0; k < 4; ++k) { const v4u xv = xr7[j + k]; \
            o[0] += cw[k][0] * bf_lo(xv.x); o[1] += cw[k][1] * bf_hi(xv.x); o[2] += cw[k][2] * bf_lo(xv.y); o[3] += cw[k][3] * bf_hi(xv.y); \
            o[4] += cw[k][4] * bf_lo(xv.z); o[5] += cw[k][5] * bf_hi(xv.z); o[6] += cw[k][6] * bf_lo(xv.w); o[7] += cw[k][7] * bf_hi(xv.w); } \
        const int tok = 4 * s_tg + j; v4u w; w.x = pk2(o[0], o[1]); w.y = pk2(o[2], o[3]); w.z = pk2(o[4], o[5]); w.w = pk2(o[6], o[7]); \
        *(LAS v4u*)(lds + XCT_OFF + (buf) * XCT_BYTES + tok * 256 + ((s_chunk * 16) ^ ((tok & 7) << 4))) = w; } \
        *(LAS v4u*)(lds + GRT_OFF + (buf) * GRT_BYTES + (tid >> 2) * 64 + (tid & 3) * 16) = grv; } while (0)
    RG_LOAD(0);
    RG_CONV_WRITE(0);
    __syncthreads();
    float carry = 0.f;
    for (int i = 0; i < NT; ++i) {
        const int cur = i & 1;
        if (i + 1 < NT) RG_LOAD(i + 1);
        const LAS unsigned char* xct = lds + XCT_OFF + cur * XCT_BYTES; const LAS unsigned char* grt = lds + GRT_OFF + cur * GRT_BYTES;
        float hl[2][4], pl[2][4], gate[2][4], Pex[2], Hex[2], P16[2], H16[2];
#pragma unroll
        for (int g = 0; g < 2; ++g) {
            const int tokb = 32 * ts + 16 * g;
            f32x4 accA = {0.f, 0.f, 0.f, 0.f}, accX = {0.f, 0.f, 0.f, 0.f};
            { const int tok = tokb + fr;
#pragma unroll
              for (int ks = 0; ks < 4; ++ks) { const bf16x8 A = *(const LAS bf16x8*)(xct + tok * 256 + (((4 * ks + fq) * 16) ^ ((tok & 7) << 4)));
                  accA = __builtin_amdgcn_mfma_f32_16x16x32_bf16(A, Ba[ks], accA, 0, 0, 0); accX = __builtin_amdgcn_mfma_f32_16x16x32_bf16(A, Bx[ks], accX, 0, 0, 0); } }
            float av[4], uv[4];
#pragma unroll
            for (int e = 0; e < 4; ++e) { const int tok = tokb + 4 * fq + e;
                const float xcv = __uint_as_float((unsigned)*(const LAS unsigned short*)(xct + tok * 256 + (((oc >> 3) * 16) ^ ((tok & 7) << 4)) + (oc & 7) * 2) << 16);
                const float gv = __uint_as_float((unsigned)*(const LAS unsigned short*)(grt + tok * 64 + (cg * 16 + fr) * 2) << 16);
                const float r = sigmoidf_fast(accA[e] + b_a), ig = sigmoidf_fast(accX[e] + b_x);
                const float aa = __builtin_amdgcn_exp2f(-cl * r);
                av[e] = aa; uv[e] = __builtin_amdgcn_sqrtf(fmaxf(1.0f - aa * aa, 0.f)) * ig * xcv;
                const float inner = 0.7978845608028654f * (gv + 0.044715f * gv * gv * gv);
                gate[g][e] = gv * sigmoidf_fast(2.0f * inner); }
            hl[g][0] = uv[0]; pl[g][0] = av[0];
#pragma unroll
            for (int e = 1; e < 4; ++e) { hl[g][e] = av[e] * hl[g][e - 1] + uv[e]; pl[g][e] = pl[g][e - 1] * av[e]; }
            float P = pl[g][3], H = hl[g][3];
            { const float Pl = __shfl_up(P, 16), Hl = __shfl_up(H, 16); if (fq >= 1) { H = P * Hl + H; P = Pl * P; } }
            { const float Pl = __shfl_up(P, 32), Hl = __shfl_up(H, 32); if (fq >= 2) { H = P * Hl + H; P = Pl * P; } }
            { const float Pe = __shfl_up(P, 16), He = __shfl_up(H, 16); Pex[g] = fq >= 1 ? Pe : 1.0f; Hex[g] = fq >= 1 ? He : 0.0f; }
            P16[g] = __shfl(P, 48 + fr); H16[g] = __shfl(H, 48 + fr);
        }
        { const float P32 = P16[0] * P16[1], H32 = P16[1] * H16[0] + H16[1];
          if (fq == 0) *(LAS f32x2*)(lds + SUM_OFF + cur * 1024 + ((cg * 4 + ts) * 16 + fr) * 8) = (f32x2){P32, H32}; }
        __syncthreads();
        float cin;
        { const f32x2 s0 = *(const LAS f32x2*)(lds + SUM_OFF + cur * 1024 + ((cg * 4 + 0) * 16 + fr) * 8), s1 = *(const LAS f32x2*)(lds + SUM_OFF + cur * 1024 + ((cg * 4 + 1) * 16 + fr) * 8),
                 s2 = *(const LAS f32x2*)(lds + SUM_OFF + cur * 1024 + ((cg * 4 + 2) * 16 + fr) * 8), s3 = *(const LAS f32x2*)(lds + SUM_OFF + cur * 1024 + ((cg * 4 + 3) * 16 + fr) * 8);
          const float c0 = carry, c1 = s0.x * c0 + s0.y, c2 = s1.x * c1 + s1.y, c3 = s2.x * c2 + s2.y, c4 = s3.x * c3 + s3.y;
          cin = ts == 0 ? c0 : (ts == 1 ? c1 : (ts == 2 ? c2 : c3)); carry = c4; }
#pragma unroll
        for (int g = 0; g < 2; ++g) {
            const float cgin = g == 0 ? cin : (P16[0] * cin + H16[0]);
            const float clane = Pex[g] * cgin + Hex[g];
#pragma unroll
            for (int e = 0; e < 4; ++e) { const int tok = 32 * ts + 16 * g + 4 * fq + e; const float h = hl[g][e] + pl[g][e] * clane;
                *(LAS unsigned short*)(lds + OUT_OFF + tok * 64 + (cg * 16 + fr) * 2) = (unsigned short)f2bf(h * gate[g][e]); }
        }
        if (i + 1 < NT) RG_CONV_WRITE(cur ^ 1);
        __syncthreads();
        { const v4u o = *(const LAS v4u*)(lds + OUT_OFF + (tid >> 2) * 64 + (tid & 3) * 16); *(v4u*)(out_base + (size_t)(i * RT + (tid >> 2)) * DM) = o;
          float sq = 0.f;
#pragma unroll
          for (int e = 0; e < 4; ++e) { const float lo_ = __uint_as_float(o[e] << 16), hi_ = __uint_as_float(o[e] & 0xffff0000u); sq += lo_ * lo_ + hi_ * hi_; }
          sq += sxf<1>(sq); sq += sxf<2>(sq);
          if ((tid & 3) == 0) part[(size_t)(b * SEQ + i * RT + (tid >> 2)) * 128 + 64 + n * 4 + cq] = sq; }
    }
    __syncthreads();
#undef RG_LOAD
#undef RG_CONV_WRITE
}
}

namespace att {
typedef short bf16x8 __attribute__((ext_vector_type(8)));
typedef short s16x4 __attribute__((ext_vector_type(4)));
typedef float f32x16 __attribute__((ext_vector_type(16)));
constexpr int KVBLK = 64, SHM_V = KVBLK * 128 * 2, SHM_K = SHM_V, FLAG_OFF = 2 * SHM_V + 2 * SHM_K;
#define ATT_KSWZ(row, colB) ((row) * 256 + ((colB) ^ (((row) & 7) << 4)))
#define ATT_SBAR() __builtin_amdgcn_sched_barrier(0)
__device__ __forceinline__ int crow(int r, int hi) { return (r & 3) + 8 * (r >> 2) + 4 * hi; }
__device__ __forceinline__ unsigned cvtpk(float lo, float hi) { unsigned r; asm volatile("v_cvt_pk_bf16_f32 %0, %1, %2" : "=v"(r) : "v"(lo), "v"(hi)); return r; }
__device__ __forceinline__ int v_st(int k, int c) { const int kk = (k & ~0xC) | ((k & 4) << 1) | ((k & 8) >> 1); return ((kk >> 3) * 4 + (c >> 5)) * 512 + ((kk & 7) * 32 + (c & 31)) * 2; }
__device__ __forceinline__ int v_rd_base(int lane) { return ((lane & 3) << 3) | (((lane >> 2) & 3) << 6) | (((lane >> 4) & 1) << 5) | (((lane >> 5) & 1) << 8); }
constexpr int v_rd_off(int d0, int ks, int half) { return d0 * 512 + ks * 4096 + half * 2048; }
template <int OFF> __device__ __forceinline__ s16x4 tr_read(int vb) { s16x4 r; asm volatile("ds_read_b64_tr_b16 %0, %1 offset:%2" : "=&v"(r) : "v"(vb), "i"(OFF) : "memory"); return r; }
template <int D0> __device__ __forceinline__ void pv_one(f32x16& od, int vb, bf16x8 pa0, bf16x8 pa1, bf16x8 pa2, bf16x8 pa3) {
    const s16x4 l0 = tr_read<v_rd_off(D0, 0, 0)>(vb), h0 = tr_read<v_rd_off(D0, 0, 1)>(vb), l1 = tr_read<v_rd_off(D0, 1, 0)>(vb), h1 = tr_read<v_rd_off(D0, 1, 1)>(vb);
    const s16x4 l2 = tr_read<v_rd_off(D0, 2, 0)>(vb), h2 = tr_read<v_rd_off(D0, 2, 1)>(vb), l3 = tr_read<v_rd_off(D0, 3, 0)>(vb), h3 = tr_read<v_rd_off(D0, 3, 1)>(vb);
    asm volatile("s_waitcnt lgkmcnt(0)" ::: "memory"); ATT_SBAR();
#define ATT_PK(L, H) (bf16x8){L[0], L[1], L[2], L[3], H[0], H[1], H[2], H[3]}
    od = __builtin_amdgcn_mfma_f32_32x32x16_bf16(pa0, ATT_PK(l0, h0), od, 0, 0, 0);
    od = __builtin_amdgcn_mfma_f32_32x32x16_bf16(pa1, ATT_PK(l1, h1), od, 0, 0, 0);
    od = __builtin_amdgcn_mfma_f32_32x32x16_bf16(pa2, ATT_PK(l2, h2), od, 0, 0, 0);
    od = __builtin_amdgcn_mfma_f32_32x32x16_bf16(pa3, ATT_PK(l3, h3), od, 0, 0, 0);
#undef ATT_PK
}
__device__ __forceinline__ void sb_block(f32x16& P, float& Crow, int KB, int trow, int hi, bool diag) {
    float sp[16];
#pragma unroll
    for (int r = 0; r < 16; ++r) { const float y = P[r]; sp[r] = fmaxf(y, 0.f) + __builtin_amdgcn_logf(1.0f + __builtin_amdgcn_exp2f(-fabsf(y))); }
    if (diag) {
#pragma unroll
        for (int r = 0; r < 16; ++r) if (KB + crow(r, hi) >= trow) sp[r] = 0.f;
    }
    float lo[4], hh[4];
#pragma unroll
    for (int k = 0; k < 4; ++k) { const float g = (sp[4 * k] + sp[4 * k + 1]) + (sp[4 * k + 2] + sp[4 * k + 3]);
        auto rr = __builtin_amdgcn_permlane32_swap(__float_as_uint(g), __float_as_uint(g), false, false);
        lo[k] = __uint_as_float(rr[0]); hh[k] = __uint_as_float(rr[1]); }
    float tot = Crow;
#pragma unroll
    for (int k = 3; k >= 0; --k) {
        const float after = tot + (hi == 0 ? hh[k] : 0.f);
        const float c3 = after + sp[4 * k + 3], c2 = c3 + sp[4 * k + 2], c1 = c2 + sp[4 * k + 1], c0 = c1 + sp[4 * k];
        P[4 * k + 3] = __builtin_amdgcn_exp2f(P[4 * k + 3] - c3); P[4 * k + 2] = __builtin_amdgcn_exp2f(P[4 * k + 2] - c2);
        P[4 * k + 1] = __builtin_amdgcn_exp2f(P[4 * k + 1] - c1); P[4 * k] = __builtin_amdgcn_exp2f(P[4 * k] - c0);
        tot += lo[k] + hh[k];
    }
    Crow = tot;
    if (diag) {
#pragma unroll
        for (int r = 0; r < 16; ++r) if (KB + crow(r, hi) >= trow) P[r] = 0.f;
    }
}

__device__ __forceinline__ void attn_unit(const bf16* proj, bf16* mixed, float* part, LAS unsigned char* lds, int unit) {
    int tid_ = threadIdx.x; asm volatile("" : "+v"(tid_));
    const int tid = tid_, wid = __builtin_amdgcn_readfirstlane(tid >> 6), lane = tid & 63, r32 = lane & 31, hi = lane >> 5;
    const int qb = unit & 15, h = (unit >> 4) & 15, b = unit >> 8, q0 = qb * 256;
    LAS unsigned char* V_lds = lds; LAS unsigned char* K_lds = lds + 2 * SHM_V; volatile LAS int* flags = (volatile LAS int*)(lds + FLAG_OFF);
    const bf16* Kh = proj + (size_t)b * SEQ * DIN + COL_K + h * HD; const bf16* Vh = proj + (size_t)b * SEQ * DIN + COL_V + h * HD;
    f32x16 o[4];
#pragma unroll
    for (int d = 0; d < 4; ++d)
#pragma unroll
        for (int r = 0; r < 16; ++r) o[d][r] = 0.f;
    bf16x8 qr[8];
    { const bf16* Qw = proj + (size_t)(b * SEQ + q0 + wid * 32 + r32) * DIN + COL_Q + h * HD + hi * 8;
#pragma unroll
      for (int d0 = 0; d0 < 8; ++d0) qr[d0] = *(const bf16x8*)(Qw + d0 * 16); }
    const int trow = q0 + wid * 32 + r32, jw = 4 * qb + (wid >> 1), jmax = 4 * qb + 3;
    const int sr = tid >> 4, sc = (tid & 15) * 8, vst0 = v_st(sr, sc), vst1 = v_st(32 + sr, sc);
    const int vb0 = (int)(unsigned)(size_t)V_lds + v_rd_base(lane);
    bf16x8 vs0, vs1, ks0, ks1;
#define ATT_SLOAD(k0) do { vs0 = *(const bf16x8*)(Vh + (size_t)((k0) + sr) * DIN + sc); vs1 = *(const bf16x8*)(Vh + (size_t)((k0) + 32 + sr) * DIN + sc); \
        ks0 = *(const bf16x8*)(Kh + (size_t)((k0) + sr) * DIN + sc); ks1 = *(const bf16x8*)(Kh + (size_t)((k0) + 32 + sr) * DIN + sc); } while (0)
#define ATT_SWRITE(bb) do { *(LAS bf16x8*)(V_lds + (bb) * SHM_V + vst0) = vs0; *(LAS bf16x8*)(V_lds + (bb) * SHM_V + vst1) = vs1; \
        *(LAS bf16x8*)(K_lds + (bb) * SHM_K + ATT_KSWZ(sr, sc * 2)) = ks0; *(LAS bf16x8*)(K_lds + (bb) * SHM_K + ATT_KSWZ(32 + sr, sc * 2)) = ks1; } while (0)
    ATT_SLOAD(jmax * KVBLK); ATT_SWRITE(0);
    __syncthreads();
    float Crow = 0.f; bool wdone = false;
    for (int j = jmax, it = 0; j >= 0; --j, ++it) {
        const int cb = it & 1;
        if (j > 0) ATT_SLOAD((j - 1) * KVBLK);
        if (j <= jw && !wdone) {
            f32x16 p0, p1;
#pragma unroll
            for (int r = 0; r < 16; ++r) { p0[r] = 0.f; p1[r] = 0.f; }
            const LAS unsigned char* Ks = K_lds + cb * SHM_K;
#pragma unroll
            for (int d0 = 0; d0 < 8; ++d0) { const int cbyte = (d0 * 16 + hi * 8) * 2;
                const bf16x8 b0 = *(const LAS bf16x8*)(Ks + ATT_KSWZ(r32, cbyte)), b1 = *(const LAS bf16x8*)(Ks + ATT_KSWZ(32 + r32, cbyte));
                p0 = __builtin_amdgcn_mfma_f32_32x32x16_bf16(b0, qr[d0], p0, 0, 0, 0); p1 = __builtin_amdgcn_mfma_f32_32x32x16_bf16(b1, qr[d0], p1, 0, 0, 0); }
            const bool diag = (64 * j + 63 >= q0 + wid * 32);
            sb_block(p1, Crow, 64 * j + 32, trow, hi, diag);
            sb_block(p0, Crow, 64 * j, trow, hi, diag);
            bf16x8 pa0, pa1, pa2, pa3;
#define ATT_PK4(P, BASE, OUT) do { unsigned a0 = cvtpk(P[BASE + 0], P[BASE + 1]), a1 = cvtpk(P[BASE + 2], P[BASE + 3]); \
        unsigned b0_ = cvtpk(P[BASE + 4], P[BASE + 5]), b1_ = cvtpk(P[BASE + 6], P[BASE + 7]); \
        auto r0 = __builtin_amdgcn_permlane32_swap(a0, b0_, false, false); auto r1 = __builtin_amdgcn_permlane32_swap(a1, b1_, false, false); \
        v4u w_ = {r0[0], r1[0], r0[1], r1[1]}; OUT = *reinterpret_cast<bf16x8*>(&w_); } while (0)
            ATT_PK4(p0, 0, pa0); ATT_PK4(p0, 8, pa1); ATT_PK4(p1, 0, pa2); ATT_PK4(p1, 8, pa3);
#undef ATT_PK4
            const int vb = vb0 + cb * SHM_V;
            pv_one<0>(o[0], vb, pa0, pa1, pa2, pa3); pv_one<1>(o[1], vb, pa0, pa1, pa2, pa3); pv_one<2>(o[2], vb, pa0, pa1, pa2, pa3); pv_one<3>(o[3], vb, pa0, pa1, pa2, pa3);
            wdone = __all(Crow > C2_EXIT);
        }
        if (lane == 0) flags[(it & 1) * 8 + wid] = (j <= jw && wdone) ? 1 : 0;
        if (j > 0) ATT_SWRITE(cb ^ 1);
        __syncthreads();
        if (j > 0) { const int f = flags[(it & 1) * 8 + (lane & 7)]; if (__all(f != 0)) break; }
    }
    { LAS unsigned char* stg = lds + wid * 8192;
#pragma unroll
      for (int d0 = 0; d0 < 4; ++d0)
#pragma unroll
          for (int r = 0; r < 16; ++r) *(LAS unsigned short*)(stg + crow(r, hi) * 256 + (d0 * 32 + r32) * 2) = (unsigned short)f2bf(o[d0][r]);
      asm volatile("s_waitcnt lgkmcnt(0)" ::: "memory");
      bf16* Ob = mixed + (size_t)(b * SEQ + q0 + wid * 32) * DM + h * HD;
#pragma unroll
      for (int k = 0; k < 8; ++k) { const int id = lane + 64 * k, row = id >> 4, ch = id & 15; const v4u v = *(const LAS v4u*)(stg + row * 256 + ch * 16); *(v4u*)(Ob + (size_t)row * DM + ch * 8) = v;
          float sq = 0.f;
#pragma unroll
          for (int e = 0; e < 4; ++e) { const float lo_ = __uint_as_float(v[e] << 16), hi_ = __uint_as_float(v[e] & 0xffff0000u); sq += lo_ * lo_ + hi_ * hi_; }
          sq += sxf<1>(sq); sq += sxf<2>(sq); sq += sxf<4>(sq); sq += sxf<8>(sq);
          if (ch == 0) part[(size_t)(b * SEQ + q0 + wid * 32 + row) * 128 + h] = sq; } }
    __syncthreads();
#undef ATT_SLOAD
#undef ATT_SWRITE
}
}

__device__ __forceinline__ void late_weight_conversion(const Args& a, unsigned char* ws, LAS unsigned char* lds, int gw, int NGW, int wave, int lane) {
    LAS unsigned* scr = (LAS unsigned*)(lds + wave * 16384);
    constexpr int I_OUT = (DM / 64) * (DM / 64), I_G = (DM / 64) * (DFF / 64), I_DN = (DK2 / 64) * (DM / 64), I_DN8 = (DK1 / 64) * (DM / 64);
    constexpr int NITEMS = I_OUT + 2 * I_G;
#define TR_DECODE(T, IT) do { int r = (IT); \
        if (r < I_OUT) { T = tr_make(a.w_out, DM, DM, (bf16*)(ws + WS_WOUT), 0, nullptr, r); { const int k0_ = 64 * (r / (DM / 64)); T.gain = k0_ < DA ? a.g_attn_out + k0_ : a.g_rnn_out + (k0_ - DA); } break; } r -= I_OUT; \
        if (r < I_G) { T = tr_make(a.w_ffn_gate, DM, DFF, (bf16*)(ws + WS_WGU), 1, a.g_ffn, r); break; } r -= I_G; \
        { T = tr_make(a.w_ffn_up, DM, DFF, (bf16*)(ws + WS_WGU), 2, a.g_ffn, r); } } while (0)
    if (gw < NITEMS) {
        TrItem ta, tb; f32x4 va[16], vb[16];
        TR_DECODE(ta, gw); tr_load(ta, va, lane);
        for (int it = gw;;) {
            { const int itn = it + NGW; const bool has = itn < NITEMS; const int itc = has ? itn : it; TR_DECODE(tb, itc); tr_load(tb, vb, lane);
              tr_process(ta, va, scr, lane); if (!has) break; it = itn; }
            { const int itn = it + NGW; const bool has = itn < NITEMS; const int itc = has ? itn : it; TR_DECODE(ta, itc); tr_load(ta, va, lane);
              tr_process(tb, vb, scr, lane); if (!has) break; it = itn; }
        }
    }
#undef TR_DECODE
}

__device__ __forceinline__ void ple_side_work(const Args& a, unsigned char* ws, bf16* PE, LAS unsigned char* lds, int ww, int nw, int wave, int lane) {
    LAS unsigned* scr = (LAS unsigned*)(lds + wave * 16384);
    constexpr int I_PG = (DM / 64) * (DM / 64);
#define TR8_PP(NIT, MAKE, SCALE) do { if (ww < (NIT)) { TrItem ta, tb; f32x4 va[16], vb[16]; MAKE(ta, ww); tr8_load(ta, va, lane); \
        for (int it = ww;;) { \
            { const int itn = it + nw; const bool has = itn < (NIT); const int itc = has ? itn : it; MAKE(tb, itc); tr8_load(tb, vb, lane); tr8_process(ta, va, SCALE, scr, lane); if (!has) break; it = itn; } \
            { const int itn = it + nw; const bool has = itn < (NIT); const int itc = has ? itn : it; MAKE(ta, itc); tr8_load(ta, va, lane); tr8_process(tb, vb, SCALE, scr, lane); if (!has) break; it = itn; } } } } while (0)
#define MK_DN8(T, IT) do { const int kb_ = (IT) >> 6, nb_ = (IT) & 63; T.src = a.w_ffn_down + (size_t)(64 * kb_) * DM + 64 * nb_; T.N = DM; T.K = DPITCH; T.keep = 0; T.scale = 1.0f; T.gain = nullptr; \
        T.dst = (bf16*)(ws + WS_WDN + (size_t)(64 * nb_) * DPITCH + 64 * kb_); } while (0)
    TR8_PP((DK1 / 64) * (DM / 64), MK_DN8, WDN_SCALE);
#undef MK_DN8
    { constexpr int I_DN = (DK2 / 64) * (DM / 64);
#define DN_DECODE(T, IT) do { T = tr_make(a.w_ffn_down + (size_t)DK1 * DM, DPITCH / 2, DM, (bf16*)(ws + WS_WDN + DK1), 0, nullptr, (IT)); T.scale = WDN_SCALE; } while (0)
      if (ww < I_DN) { TrItem ta, tb; f32x4 va[16], vb[16];
          DN_DECODE(ta, ww); tr_load(ta, va, lane);
          for (int it = ww;;) {
              { const int itn = it + nw; const bool has = itn < I_DN; const int itc = has ? itn : it; DN_DECODE(tb, itc); tr_load(tb, vb, lane);
                tr_process(ta, va, scr, lane); if (!has) break; it = itn; }
              { const int itn = it + nw; const bool has = itn < I_DN; const int itc = has ? itn : it; DN_DECODE(ta, itc); tr_load(ta, va, lane);
                tr_process(tb, vb, scr, lane); if (!has) break; it = itn; }
          } }
#undef DN_DECODE
    }
#define MK_PG(T, IT) do { const int kb_ = (IT) >> 6, nb_ = (IT) & 63; T.src = a.w_ple_gate + (size_t)(64 * kb_) * DM + 64 * nb_; T.N = DM; T.K = DM; T.keep = 0; T.scale = 1.0f; T.gain = a.g_ple + 64 * kb_; \
        T.dst = (bf16*)(ws + WS_WPG + (size_t)(64 * nb_) * DM + 64 * kb_); } while (0)
    TR8_PP(I_PG, MK_PG, 128.0f);
#undef MK_PG
#undef TR8_PP
}

constexpr int CW_BAR = 4096;
constexpr size_t CTL_ZERO_BYTES = 384 * 1024;
constexpr int MISC_OFF = 131072;

__global__ void __launch_bounds__(NWAVES * 64, 2) mega_fwd(Args a) {
    extern __shared__ __attribute__((aligned(16))) unsigned char lds_raw[];
    LAS unsigned char* lds = (LAS unsigned char*)lds_raw;
    const int tid = threadIdx.x, lane = tid & 63, wave = __builtin_amdgcn_readfirstlane(tid >> 6);
    const int G = gridDim.x, gw = blockIdx.x * NWAVES + wave, NGW = G * NWAVES;
    unsigned char* ws = a.ws; float* out = a.out;
    bf16 *A1 = (bf16*)(ws + WS_A1), *A2 = (bf16*)(ws + WS_A2), *PE = (bf16*)(ws + WS_PE), *PB = (bf16*)(ws + WS_PB), *HB = (bf16*)(ws + WS_HB), *HID = (bf16*)(ws + WS_HID), *XB = (bf16*)out;
    unsigned long long *SS1 = (unsigned long long*)(ws + WS_SS1), *SS2 = (unsigned long long*)(ws + WS_SS2);
    for (int u = tid; u < (LDS_BYTES - MISC_OFF) / 4; u += NWAVES * 64) ((LAS unsigned*)(lds + MISC_OFF))[u] = 0u;
    __syncthreads();
    XcdBarrier bar = xcd_barrier_post((unsigned*)(ws + WS_CTL) + CW_BAR, (volatile LAS unsigned*)(lds + MISC_OFF));
#define GRID_BAR() xcd_barrier(bar)

    {
        LAS unsigned* scr = (LAS unsigned*)(lds + wave * 16384);
        constexpr int I_IN = (DM / 64) * (DIN / 64), I_PP = (PLE / 64) * (DM / 64), I_RG = 16 * 4;
        constexpr int NITEMS = I_IN + I_PP + 2 * I_RG;
#define TR_DECODE(T, IT) do { int r = (IT); \
            if (r < I_IN) { T = tr_make(a.w_in, DM, DIN, (bf16*)(ws + WS_WIN), 0, a.g_mix, r); break; } r -= I_IN; \
            if (r < I_PP) { T = tr_make(a.w_ple_proj, PLE, DM, (bf16*)(ws + WS_WPP), 0, nullptr, r); break; } r -= I_PP; \
            if (r < I_RG) { const int blk = r / 4; T = tr_make(a.w_rg_a + (size_t)blk * 16384, 128, 128, (bf16*)(ws + WS_WRA) + (size_t)blk * 16384, 0, nullptr, r % 4); break; } r -= I_RG; \
            { const int blk = r / 4; T = tr_make(a.w_rg_x + (size_t)blk * 16384, 128, 128, (bf16*)(ws + WS_WRX) + (size_t)blk * 16384, 0, nullptr, r % 4); } } while (0)
        if (gw < NITEMS) {
            TrItem ta, tb; f32x4 va[16], vb[16];
            TR_DECODE(ta, gw); ta.keep = 1; tr_load(ta, va, lane);
            for (int it = gw;;) {
                { const int itn = it + NGW; const bool has = itn < NITEMS; const int itc = has ? itn : it; TR_DECODE(tb, itc); tb.keep = 1; tr_load(tb, vb, lane);
                  tr_process(ta, va, scr, lane); if (!has) break; it = itn; }
                { const int itn = it + NGW; const bool has = itn < NITEMS; const int itc = has ? itn : it; TR_DECODE(ta, itc); ta.keep = 1; tr_load(ta, va, lane);
                  tr_process(tb, vb, scr, lane); if (!has) break; it = itn; }
            }
        }
#undef TR_DECODE
        cast_rows(a.x, XB, (signed char*)out + (size_t)128 * MiB, (float*)(ws + WS_RSX), gw, NGW, lane);
        { const f32x4* src = (const f32x4*)a.p; v2u* dst = (v2u*)PB; const size_t n4 = (size_t)M * PLE / 4;
          for (size_t i = (size_t)blockIdx.x * 512 + tid; i < n4; i += (size_t)G * 512) { const f32x4 v = src[i]; v2u w; w.x = pk2(v.x, v.y); w.y = pk2(v.z, v.w); dst[i] = w; } }
    }
    GRID_BAR();
    { int lane1; asm volatile("v_mbcnt_lo_u32_b32 %0, -1, 0\n\tv_mbcnt_hi_u32_b32 %0, -1, %0" : "=v"(lane1));
      quant_rows_i8((const bf16*)(ws + WS_WIN), (signed char*)out + (size_t)192 * MiB, (float*)(ws + WS_SBIN), NI8, gw, NGW, lane1); }
    {
        pg8::Gemm g{XB, (const bf16*)(ws + WS_WIN) + (size_t)NI8 * DM, M, DIN - NI8, DM, 0}; pg8::StaticOrder S; S.init(M, DIN - NI8, G, (int)blockIdx.x);
        pg8::EpiBf16S E{A2 + NI8, (const float*)(ws + WS_RSX), DIN, 0, 1.0f, 0};
        pg8::gemm_phase<pg8::EpiBf16S, pg8::StaticOrder, true, true>(lds, g, S, E);
    }
    {
        pg8::Gemm g{PB, (const bf16*)(ws + WS_WPP), M, DM, PLE, 0}; pg8::StaticOrder S; S.init(M, DM, G, (int)blockIdx.x);
        pg8::EpiPe E{PE, a.g_ple_out, (float*)(ws + WS_HB8), DM, 0};
        pg8::gemm_phase<pg8::EpiPe, pg8::StaticOrder, true, true>(lds, g, S, E);
    }
    GRID_BAR();
    { int lane1b; asm volatile("v_mbcnt_lo_u32_b32 %0, -1, 0\n\tv_mbcnt_hi_u32_b32 %0, -1, %0" : "=v"(lane1b));
      const float* part = (const float*)(ws + WS_HB8); float* rspe = (float*)(ws + WS_SS1);
      for (int m = gw; m < M; m += NGW) { const float v = wave_sum(part[(size_t)m * 64 + lane1b]); if (lane1b == 0) rspe[m] = __builtin_amdgcn_rsqf(v * (1.0f / 4096.0f) + NORM_EPS); } }
    {
        pg8::Gemm g{(const bf16*)((const signed char*)out + (size_t)128 * MiB), (const bf16*)((const signed char*)out + (size_t)192 * MiB), M, NI8, DM, 0}; pg8::StaticOrder S; S.init(M, NI8, G, (int)blockIdx.x);
        pg8::EpiBf16Si8 E{A2, (const float*)(ws + WS_RSXQ), (const float*)(ws + WS_SBIN), DIN, DA / 256, QSCALE, 0};
        pg8::gemm_phase_i8<pg8::EpiBf16Si8, pg8::StaticOrder>(lds, g, S, E);
    }
    GRID_BAR();
    const bool conv_first = ((blockIdx.x >> 3) & 1) != 0;
    if (conv_first) late_weight_conversion(a, ws, lds, gw, NGW, wave, lane);
    __syncthreads();
    for (int u = blockIdx.x; u < NB * 16 * 4; u += G) rg::rglru_unit(a, A2, A1, (float*)(ws + WS_HB8), (const bf16*)(ws + WS_WRA), (const bf16*)(ws + WS_WRX), lds, u);
    for (int u = blockIdx.x; u < NB * NH * (SEQ / 256); u += G) att::attn_unit(A2, A1, (float*)(ws + WS_HB8), lds, u);
    __syncthreads();
    if (!conv_first) late_weight_conversion(a, ws, lds, gw, NGW, wave, lane);
    GRID_BAR();
    { int lane5; asm volatile("v_mbcnt_lo_u32_b32 %0, -1, 0\n\tv_mbcnt_hi_u32_b32 %0, -1, %0" : "=v"(lane5));
      { const float* part = (const float*)(ws + WS_HB8); float* rat = (float*)(ws + WS_RSX); float* rsr = (float*)(ws + WS_RSXQ);
        for (int m = gw; m < M; m += NGW) { const float sa = wave_sum(lane5 < 16 ? part[(size_t)m * 128 + lane5] : 0.f), sr = wave_sum(part[(size_t)m * 128 + 64 + lane5]);
            const float ra = __builtin_amdgcn_rsqf(sa * (1.0f / 2048.0f) + NORM_EPS), rr = __builtin_amdgcn_rsqf(sr * (1.0f / 2048.0f) + NORM_EPS);
            if (lane5 == 0) { rat[m] = ra / rr; rsr[m] = rr; } } }
      quant_rows_i8((const bf16*)(ws + WS_WGU), (signed char*)out + (size_t)128 * MiB, (float*)(ws + WS_SB), NGU, gw, NGW, lane5); }
    GRID_BAR();
    { unsigned char* w_ = a.ws; float* o_ = a.out; asm volatile("" : "+s"(w_), "+s"(o_));
    {
        pg8::Gemm g{((bf16*)(w_ + WS_A1)), (const bf16*)(w_ + WS_WOUT), M, DM, DM, 0}; pg8::StaticOrder S; S.init(M, DM, G, (int)blockIdx.x);
        pg8::EpiResMid E{{nullptr, ((bf16*)(w_ + WS_HB)), nullptr, nullptr, ((bf16*)o_), DM, 1.0f}, (const float*)(w_ + WS_RSX), (const float*)(w_ + WS_RSXQ)};
        pg8::gemm_phase<pg8::EpiResMid, pg8::StaticOrder, true, true>(lds, g, S, E);
    }
    GRID_BAR();
    }
    { unsigned char* w_ = a.ws; float* o_ = a.out; asm volatile("" : "+s"(w_), "+s"(o_));
    { int lane7; asm volatile("v_mbcnt_lo_u32_b32 %0, -1, 0\n\tv_mbcnt_hi_u32_b32 %0, -1, %0" : "=v"(lane7));
      quant_rows_i8<true>(((bf16*)(w_ + WS_HB)), (signed char*)o_, (float*)(w_ + WS_SA), M, gw, NGW, lane7); }
    GRID_BAR();
    }
    { unsigned char* w_ = a.ws; float* o_ = a.out; asm volatile("" : "+s"(w_), "+s"(o_));
    {
        pg8::Gemm g{(const bf16*)o_, (const bf16*)((const signed char*)o_ + (size_t)128 * MiB), M, NGU, DM, 0}; pg8::StaticOrder S; S.init(M, NGU, G, (int)blockIdx.x);
        pg8::EpiSwiGLUi8 E{(unsigned char*)((bf16*)(w_ + WS_HID)), (const float*)(w_ + WS_SA), (const float*)(w_ + WS_SB), DPITCH, DK1};
        pg8::gemm_phase_i8<pg8::EpiSwiGLUi8, pg8::StaticOrder>(lds, g, S, E);
        const int rounds = (S.nwg + G - 1) / G, full_last = S.nwg - (rounds - 1) * G, nshort = G - full_last, c = (int)blockIdx.x;
        int lane8; asm volatile("v_mbcnt_lo_u32_b32 %0, -1, 0\n\tv_mbcnt_hi_u32_b32 %0, -1, %0" : "=v"(lane8));
        if (nshort == 0) ple_side_work(a, w_, ((bf16*)(w_ + WS_PE)), lds, c * NWAVES + wave, G * NWAVES, wave, lane8);
        else if (c >= full_last) ple_side_work(a, w_, ((bf16*)(w_ + WS_PE)), lds, (c - full_last) * NWAVES + wave, nshort * NWAVES, wave, lane8);
    }
    GRID_BAR();
    }
    { unsigned char* w_ = a.ws; float* o_ = a.out; asm volatile("" : "+s"(w_), "+s"(o_));
    {
        pg8::Gemm g{((bf16*)(w_ + WS_HID)), (const bf16*)(w_ + WS_WDN), M, DM, DPITCH, 0}; pg8::StaticOrder S; S.init(M, DM, G, (int)blockIdx.x, 2);
        pg8::EpiRes<true, false> E{nullptr, ((bf16*)(w_ + WS_HB)), ((unsigned long long*)(w_ + WS_SS2)), w_ + WS_HB8, nullptr, DM, 1.0f / (HID_SCALE * WDN_SCALE)};
        pg8::gemm_phase_fp8<pg8::EpiRes<true, false>, pg8::StaticOrder, DN8>(lds, g, S, E);
    }
    GRID_BAR();
    }
    { unsigned char* w_ = a.ws; float* o_ = a.out; asm volatile("" : "+s"(w_), "+s"(o_));
    {
        pg8::Gemm g{(const bf16*)(w_ + WS_HB8), (const bf16*)(w_ + WS_WPG), M, DM, DM, 0}; pg8::StaticOrder S; S.init(M, DM, G, (int)blockIdx.x);
        pg8::EpiPleGate E{((bf16*)(w_ + WS_HB)), ((bf16*)(w_ + WS_A1)), ((bf16*)(w_ + WS_PE)), ((unsigned long long*)(w_ + WS_SS2)), (const float*)(w_ + WS_SS1), DM, 0};
        pg8::gemm_phase_fp8<pg8::EpiPleGate, pg8::StaticOrder>(lds, g, S, E);
    }
    GRID_BAR();
    }
    { unsigned char* w_ = a.ws; float* o_ = a.out; asm volatile("" : "+s"(w_), "+s"(o_));
    { int lane12; asm volatile("v_mbcnt_lo_u32_b32 %0, -1, 0\n\tv_mbcnt_hi_u32_b32 %0, -1, %0" : "=v"(lane12));
      rms_rows_b2f(((bf16*)(w_ + WS_A1)), a.g_final, o_, gw, NGW, lane12); }
    }
}

extern "C" void kernel_launch(void* const* d_in, const int* in_sizes, int n_in, void* d_out, int out_size, void* d_ws, size_t ws_size, hipStream_t stream) {
    static int grid = 0;
    if (grid == 0) {
        if (n_in != 23 || in_sizes[0] != M * DM || out_size != M * DM || ws_size < WS_END) { fprintf(stderr, "kernel_launch: unexpected shapes: n_in %d in0 %d out %d ws %zu (need %zu)\n", n_in, n_in > 0 ? in_sizes[0] : -1, out_size, ws_size, (size_t)WS_END); grid = -1; return; }
        int dev = 0, cus = 0, per_cu = 0;
        if (hipGetDevice(&dev) != hipSuccess || hipDeviceGetAttribute(&cus, hipDeviceAttributeMultiprocessorCount, dev) != hipSuccess) { grid = -1; return; }
        if (hipFuncSetAttribute((const void*)mega_fwd, hipFuncAttributeMaxDynamicSharedMemorySize, LDS_BYTES) != hipSuccess) { fprintf(stderr, "kernel_launch: hipFuncSetAttribute failed\n"); grid = -1; return; }
        if (hipOccupancyMaxActiveBlocksPerMultiprocessor(&per_cu, (const void*)mega_fwd, NWAVES * 64, LDS_BYTES) != hipSuccess || per_cu < 1) { fprintf(stderr, "kernel_launch: occupancy query says %d blocks per CU\n", per_cu); (void)hipGetLastError(); }
        grid = cus;
    }
    if (grid < 0) return;
    if (hipMemsetAsync((char*)d_ws + WS_CTL, 0, CTL_ZERO_BYTES, stream) != hipSuccess) return;
    Args a{};
    const float** ap = (const float**)&a;
    for (int i = 0; i < 23; ++i) ap[i] = (const float*)d_in[i];
    a.out = (float*)d_out; a.ws = (unsigned char*)d_ws;
    hipLaunchKernelGGL(mega_fwd, dim3(grid), dim3(NWAVES * 64), LDS_BYTES, stream, a);
}
```

```cpp
#include <hip/hip_runtime.h>
#include <cstdio>
#include <cstdint>

namespace pg8 {
#define PG8_LAS __attribute__((address_space(3)))
typedef unsigned short bf16_t;
typedef short bf16x8 __attribute__((ext_vector_type(8)));
typedef float f32x4 __attribute__((ext_vector_type(4)));
typedef unsigned u32x4 __attribute__((ext_vector_type(4)));
typedef unsigned u32x2 __attribute__((ext_vector_type(2)));
constexpr int BM = 256, BK = 64, HALF = 128, HTB = HALF * BK * 2  , STAGE_BYTES = 8 * HTB, NXCD = 8, WGM = 8;

__host__ __device__ __forceinline__ int lds_byte(int r, int c) { const int st = (r >> 4) * 2 + (c >> 5), rr = r & 15, cc = c & 31, ob = rr * 64 + cc * 2; return st * 1024 + (ob ^ (((ob >> 9) & 1) << 5)); }
__host__ __device__ __forceinline__ void stage_rc(int b, int& R, int& C) { const int st = b / 1024, sb = b % 1024, swz = sb ^ (((sb >> 9) & 1) << 5); R = (st >> 1) * 16 + swz / 64; C = (st & 1) * 32 + (swz % 64) / 2; }
__host__ __device__ __forceinline__ int perm32(int rho) { const int n = rho >> 4, i = rho & 15; return 8 * (i >> 2) + 4 * n + (i & 3); }

struct Unit { int pm, pn; };
struct Gemm { const bf16_t* A; const bf16_t* Bt; int M, N, K, pad; };

struct StaticOrder {
    int nM, nN, nwg, G, c, wgm;
    __host__ __device__ void init(int M, int N, int G_, int c_, int wgm_ = WGM) { nM = M / BM; nN = N / BM; nwg = nM * nN; G = G_; c = c_; wgm = wgm_; }
    __host__ __device__ bool next(int i, Unit& u) const {
        const long L = (long)i * G + c; if (L >= nwg) return false;
        int wgid = (int)L; { const int q = nwg / NXCD, r = nwg % NXCD, xcd = wgid % NXCD, off = wgid / NXCD; wgid = (xcd < r ? xcd * (q + 1) : r * (q + 1) + (xcd - r) * q) + off; }
        const int nig = wgm * nN, gid = wgid / nig, fm = gid * wgm, gsz = (nM - fm) < wgm ? (nM - fm) : wgm;
        u.pm = fm + ((wgid % nig) % gsz); u.pn = (wgid % nig) / gsz; return true;
    }
    __device__ __forceinline__ void a_ready(const Unit&) const {}
    __device__ __forceinline__ void done(const Unit&) const {}
};

__device__ __forceinline__ unsigned cvt_pk_bf16(float lo, float hi) { unsigned r; asm volatile("v_cvt_pk_bf16_f32 %0, %1, %2" : "=v"(r) : "v"(lo), "v"(hi)); return r; }

struct EpiBf16S {
    static constexpr bool PERM = true, AFTER_DRAIN = false;
    bf16_t* O; const float* rs; int ldc; int nscale; float sc; int pad;
    __device__ __forceinline__ void operator()(const f32x4 (&acc)[2][2][4][2], const Unit& u, int wr, int wc, int fr_in, int fq_in) const {
        int fr = fr_in, fq = fq_in; asm volatile("" : "+v"(fr), "+v"(fq));
        const int row0 = u.pm * BM + wr * 64 + fr, col0 = u.pn * BM + wc * 32 + 8 * fq;
        const float s = (u.pn < nscale) ? sc : 1.f;
#pragma unroll
        for (int ai = 0; ai < 2; ++ai)
#pragma unroll
            for (int m = 0; m < 4; ++m) { const int row = row0 + ai * HALF + m * 16; bf16_t* rowp = O + (size_t)row * ldc + col0; const float sr = rs ? s * rs[row] : s;
#pragma unroll
                for (int bj = 0; bj < 2; ++bj) { const f32x4 v0 = acc[ai][bj][m][0] * sr, v1 = acc[ai][bj][m][1] * sr;
                    u32x4 w; w.x = cvt_pk_bf16(v0[0], v0[1]); w.y = cvt_pk_bf16(v0[2], v0[3]); w.z = cvt_pk_bf16(v1[0], v1[1]); w.w = cvt_pk_bf16(v1[2], v1[3]);
                    *(u32x4*)(rowp + bj * HALF) = w; } }
    }
};
__device__ __forceinline__ float ss_to_rstd(unsigned long long v, float inv_n, float eps) { return __builtin_amdgcn_rsqf((float)v * (1.0f / 16777216.0f) * inv_n + eps); }
template <int K> __device__ __forceinline__ float sxf(float v) { return __int_as_float(__builtin_amdgcn_ds_swizzle(__float_as_int(v), (K << 10) | 0x1f)); }
template <int K> __device__ __forceinline__ unsigned sxu(unsigned v) { return (unsigned)__builtin_amdgcn_ds_swizzle((int)v, (K << 10) | 0x1f); }
__device__ __forceinline__ float sum32(float v) { auto r = __builtin_amdgcn_permlane32_swap(__float_as_uint(v), __float_as_uint(v), false, false); return __uint_as_float(r[0]) + __uint_as_float(r[1]); }
__device__ __forceinline__ float max32(float v) { auto r = __builtin_amdgcn_permlane32_swap(__float_as_uint(v), __float_as_uint(v), false, false); return fmaxf(__uint_as_float(r[0]), __uint_as_float(r[1])); }
template <bool BASE_BF, bool WIDE = true, bool SSQ = true> struct EpiRes {
    static_assert(BASE_BF, "the base is bf16: the layer input x is cast once in the prologue");
    static constexpr bool PERM = true, AFTER_DRAIN = false;
    const float* base; bf16_t* hb; unsigned long long* ss; unsigned char* h8; const bf16_t* bsrc; int ldc; float ascale;
    __device__ __forceinline__ void operator()(const f32x4 (&acc)[2][2][4][2], const Unit& u, int wr, int wc, int fr_in, int fq_in, const float (*rsr)[4] = nullptr) const {
        int fr = fr_in, fq = fq_in; asm volatile("" : "+v"(fr), "+v"(fq));
        const int row0 = u.pm * BM + wr * 64 + fr, col0 = u.pn * BM + wc * 32 + 8 * fq;
        const bf16_t* src = bsrc ? bsrc : hb;
        u32x4 bw[2][4][2];
        if constexpr (WIDE) {
#pragma unroll
        for (int ai = 0; ai < 2; ++ai)
#pragma unroll
            for (int m = 0; m < 4; ++m) { const size_t off = (size_t)(row0 + ai * HALF + m * 16) * ldc + col0;
#pragma unroll
                for (int bj = 0; bj < 2; ++bj) bw[ai][m][bj] = *(const u32x4*)(src + off + bj * HALF); }
        }
#pragma unroll
        for (int ai = 0; ai < 2; ++ai) {
            if constexpr (!WIDE) {
#pragma unroll
                for (int m = 0; m < 4; ++m) { const size_t off = (size_t)(row0 + ai * HALF + m * 16) * ldc + col0;
#pragma unroll
                    for (int bj = 0; bj < 2; ++bj) bw[ai][m][bj] = *(const u32x4*)(src + off + bj * HALF); }
            }
#pragma unroll
            for (int m = 0; m < 4; ++m) { const int row = row0 + ai * HALF + m * 16; const size_t off = (size_t)row * ldc + col0; const float ascale = rsr ? this->ascale * rsr[ai][m] : this->ascale;
                float s = 0.f;
#pragma unroll
                for (int bj = 0; bj < 2; ++bj) { const u32x4 b = bw[ai][m][bj];
                    const f32x4 o0 = (f32x4){__uint_as_float(b[0] << 16), __uint_as_float(b[0] & 0xffff0000u), __uint_as_float(b[1] << 16), __uint_as_float(b[1] & 0xffff0000u)} + acc[ai][bj][m][0] * ascale;
                    const f32x4 o1 = (f32x4){__uint_as_float(b[2] << 16), __uint_as_float(b[2] & 0xffff0000u), __uint_as_float(b[3] << 16), __uint_as_float(b[3] & 0xffff0000u)} + acc[ai][bj][m][1] * ascale;
                    u32x4 w; w.x = cvt_pk_bf16(o0[0], o0[1]); w.y = cvt_pk_bf16(o0[2], o0[3]); w.z = cvt_pk_bf16(o1[0], o1[1]); w.w = cvt_pk_bf16(o1[2], o1[3]);
                    *(u32x4*)(hb + off + bj * HALF) = w;
                    if (h8) { int q0 = 0, q1 = 0;
                        q0 = __builtin_amdgcn_cvt_pk_fp8_f32(__builtin_amdgcn_fmed3f(o0[0], -448.f, 448.f), __builtin_amdgcn_fmed3f(o0[1], -448.f, 448.f), q0, false);
                        q0 = __builtin_amdgcn_cvt_pk_fp8_f32(__builtin_amdgcn_fmed3f(o0[2], -448.f, 448.f), __builtin_amdgcn_fmed3f(o0[3], -448.f, 448.f), q0, true);
                        q1 = __builtin_amdgcn_cvt_pk_fp8_f32(__builtin_amdgcn_fmed3f(o1[0], -448.f, 448.f), __builtin_amdgcn_fmed3f(o1[1], -448.f, 448.f), q1, false);
                        q1 = __builtin_amdgcn_cvt_pk_fp8_f32(__builtin_amdgcn_fmed3f(o1[2], -448.f, 448.f), __builtin_amdgcn_fmed3f(o1[3], -448.f, 448.f), q1, true);
                        *(u32x2*)(h8 + off + bj * HALF) = (u32x2){(unsigned)q0, (unsigned)q1}; }
                    if constexpr (SSQ) s += (o0[0] * o0[0] + o0[1] * o0[1]) + (o0[2] * o0[2] + o0[3] * o0[3]) + (o1[0] * o1[0] + o1[1] * o1[1]) + (o1[2] * o1[2] + o1[3] * o1[3]); }
                if constexpr (SSQ) { s += sxf<16>(s); s = sum32(s);
                    if (fq == 0) atomicAdd(ss + row, (unsigned long long)(s * 16777216.0f)); } }
            if constexpr (!WIDE) asm volatile("" ::: "memory");
        }
    }
};
struct EpiPe {
    static constexpr bool PERM = true, AFTER_DRAIN = false;
    bf16_t* O; const float* g; float* part; int ldc; int pad;
    __device__ __forceinline__ void operator()(const f32x4 (&acc)[2][2][4][2], const Unit& u, int wr, int wc, int fr_in, int fq_in) const {
        int fr = fr_in, fq = fq_in; asm volatile("" : "+v"(fr), "+v"(fq));
        const int row0 = u.pm * BM + wr * 64 + fr, col0 = u.pn * BM + wc * 32 + 8 * fq;
        f32x4 gc[2][2];
#pragma unroll
        for (int bj = 0; bj < 2; ++bj) { gc[bj][0] = *(const f32x4*)(g + col0 + bj * HALF); gc[bj][1] = *(const f32x4*)(g + col0 + bj * HALF + 4); }
#pragma unroll
        for (int ai = 0; ai < 2; ++ai)
#pragma unroll
            for (int m = 0; m < 4; ++m) { const int row = row0 + ai * HALF + m * 16; bf16_t* rowp = O + (size_t)row * ldc + col0; float s = 0.f;
#pragma unroll
                for (int bj = 0; bj < 2; ++bj) { const f32x4 a0 = acc[ai][bj][m][0], a1 = acc[ai][bj][m][1];
                    s += (a0[0] * a0[0] + a0[1] * a0[1]) + (a0[2] * a0[2] + a0[3] * a0[3]) + (a1[0] * a1[0] + a1[1] * a1[1]) + (a1[2] * a1[2] + a1[3] * a1[3]);
                    const f32x4 v0 = a0 * gc[bj][0], v1 = a1 * gc[bj][1];
                    u32x4 w; w.x = cvt_pk_bf16(v0[0], v0[1]); w.y = cvt_pk_bf16(v0[2], v0[3]); w.z = cvt_pk_bf16(v1[0], v1[1]); w.w = cvt_pk_bf16(v1[2], v1[3]);
                    *(u32x4*)(rowp + bj * HALF) = w; }
                s += sxf<16>(s); s = sum32(s);
                if (fq == 0) part[(size_t)row * 64 + u.pn * 4 + wc] = s; }
    }
};
struct EpiSwiGLU {
    static constexpr bool PERM = true, AFTER_DRAIN = false;
    unsigned char* O; const unsigned long long* ss; int pitch; int k1;
    __device__ __forceinline__ void operator()(const f32x4 (&acc)[2][2][4][2], const Unit& u, int wr, int wc, int fr_in, int fq_in) const {
        int fr = fr_in, fq = fq_in; asm volatile("" : "+v"(fr), "+v"(fq));
        const int row0 = u.pm * BM + wr * 64 + fr, col0 = u.pn * HALF + wc * 32 + 8 * fq;
        float rs[2][4];
#pragma unroll
        for (int ai = 0; ai < 2; ++ai)
#pragma unroll
            for (int m = 0; m < 4; ++m) rs[ai][m] = ss_to_rstd(ss[row0 + ai * HALF + m * 16], 1.0f / 4096.0f, 1e-6f);
#pragma unroll
        for (int ai = 0; ai < 2; ++ai)
#pragma unroll
            for (int m = 0; m < 4; ++m) { unsigned char* rowp = O + (size_t)(row0 + ai * HALF + m * 16) * pitch;
                float r[8];
#pragma unroll
                for (int n = 0; n < 2; ++n)
#pragma unroll
                    for (int j = 0; j < 4; ++j) { const float g = acc[ai][0][m][n][j] * rs[ai][m], up = acc[ai][1][m][n][j] * rs[ai][m];
                        const float e = __builtin_amdgcn_exp2f(-1.4426950408889634f * g); r[n * 4 + j] = g * __builtin_amdgcn_rcpf(1.0f + e) * (up * 16.0f); }
                if (u.pn * HALF < k1) { int q0 = 0, q1 = 0;
                    q0 = __builtin_amdgcn_cvt_pk_fp8_f32(__builtin_amdgcn_fmed3f(r[0], -448.f, 448.f), __builtin_amdgcn_fmed3f(r[1], -448.f, 448.f), q0, false);
                    q0 = __builtin_amdgcn_cvt_pk_fp8_f32(__builtin_amdgcn_fmed3f(r[2], -448.f, 448.f), __builtin_amdgcn_fmed3f(r[3], -448.f, 448.f), q0, true);
                    q1 = __builtin_amdgcn_cvt_pk_fp8_f32(__builtin_amdgcn_fmed3f(r[4], -448.f, 448.f), __builtin_amdgcn_fmed3f(r[5], -448.f, 448.f), q1, false);
                    q1 = __builtin_amdgcn_cvt_pk_fp8_f32(__builtin_amdgcn_fmed3f(r[6], -448.f, 448.f), __builtin_amdgcn_fmed3f(r[7], -448.f, 448.f), q1, true);
                    *(u32x2*)(rowp + col0) = (u32x2){(unsigned)q0, (unsigned)q1};
                } else { u32x4 w; w.x = cvt_pk_bf16(r[0], r[1]); w.y = cvt_pk_bf16(r[2], r[3]); w.z = cvt_pk_bf16(r[4], r[5]); w.w = cvt_pk_bf16(r[6], r[7]);
                    *(u32x4*)(rowp + k1 + 2 * (col0 - k1)) = w; } }
    }
};
typedef int v4i_e __attribute__((ext_vector_type(4)));
struct EpiBf16Si8 {
    static constexpr bool PERM = true, AFTER_DRAIN = false;
    bf16_t* O; const float* rs; const float* sb; int ldc; int nscale; float sc; int pad;
    struct Pre {}; __device__ __forceinline__ Pre pre(const Unit&, int, int, int, int) const { return Pre{}; }
    __device__ __forceinline__ void operator()(const v4i_e (&acc)[2][2][4][2], const Unit& u, int wr, int wc, int fr_in, int fq_in, const Pre&) const {
        int fr = fr_in, fq = fq_in; asm volatile("" : "+v"(fr), "+v"(fq));
        const int row0 = u.pm * BM + wr * 64 + fr, col0 = u.pn * BM + wc * 32 + 8 * fq;
        const float s = (u.pn < nscale) ? sc : 1.f;
        f32x4 cs[2][2];
#pragma unroll
        for (int bj = 0; bj < 2; ++bj) { cs[bj][0] = *(const f32x4*)(sb + col0 + bj * HALF) * s; cs[bj][1] = *(const f32x4*)(sb + col0 + bj * HALF + 4) * s; }
#pragma unroll
        for (int ai = 0; ai < 2; ++ai)
#pragma unroll
            for (int m = 0; m < 4; ++m) { const int row = row0 + ai * HALF + m * 16; bf16_t* rowp = O + (size_t)row * ldc + col0; const float sr = rs[row];
#pragma unroll
                for (int bj = 0; bj < 2; ++bj) { const f32x4 v0 = __builtin_convertvector(acc[ai][bj][m][0], f32x4) * (cs[bj][0] * sr), v1 = __builtin_convertvector(acc[ai][bj][m][1], f32x4) * (cs[bj][1] * sr);
                    u32x4 w; w.x = cvt_pk_bf16(v0[0], v0[1]); w.y = cvt_pk_bf16(v0[2], v0[3]); w.z = cvt_pk_bf16(v1[0], v1[1]); w.w = cvt_pk_bf16(v1[2], v1[3]);
                    *(u32x4*)(rowp + bj * HALF) = w; } }
    }
};
struct EpiSwiGLUi8 {
    static constexpr bool PERM = true, AFTER_DRAIN = false;
    unsigned char* O; const float* sa; const float* sb; int pitch; int k1;
    struct Pre { float rs[2][4]; f32x4 sg[2], su[2]; };
    __device__ __forceinline__ Pre pre(const Unit& u, int wr, int wc, int fr_in, int fq_in) const {
        int fr = fr_in, fq = fq_in; asm volatile("" : "+v"(fr), "+v"(fq));
        const int row0 = u.pm * BM + wr * 64 + fr, wrow = u.pn * BM + wc * 32 + 8 * fq;
        Pre p;
        p.sg[0] = *(const f32x4*)(sb + wrow); p.sg[1] = *(const f32x4*)(sb + wrow + 4); p.su[0] = *(const f32x4*)(sb + wrow + HALF); p.su[1] = *(const f32x4*)(sb + wrow + HALF + 4);
#pragma unroll
        for (int ai = 0; ai < 2; ++ai)
#pragma unroll
            for (int m = 0; m < 4; ++m) p.rs[ai][m] = sa[row0 + ai * HALF + m * 16];
        return p;
    }
    __device__ __forceinline__ void operator()(const v4i_e (&acc)[2][2][4][2], const Unit& u, int wr, int wc, int fr_in, int fq_in, const Pre& p) const {
        int fr = fr_in, fq = fq_in; asm volatile("" : "+v"(fr), "+v"(fq));
        const int row0 = u.pm * BM + wr * 64 + fr, col0 = u.pn * HALF + wc * 32 + 8 * fq;
#pragma unroll
        for (int ai = 0; ai < 2; ++ai)
#pragma unroll
            for (int m = 0; m < 4; ++m) { unsigned char* rowp = O + (size_t)(row0 + ai * HALF + m * 16) * pitch;
                float r[8];
#pragma unroll
                for (int n = 0; n < 2; ++n)
#pragma unroll
                    for (int j = 0; j < 4; ++j) { const float g = (float)acc[ai][0][m][n][j] * (p.rs[ai][m] * p.sg[n][j]), up = (float)acc[ai][1][m][n][j] * (p.rs[ai][m] * p.su[n][j]);
                        const float e = __builtin_amdgcn_exp2f(-1.4426950408889634f * g); r[n * 4 + j] = g * __builtin_amdgcn_rcpf(1.0f + e) * (up * 16.0f); }
                if (u.pn * HALF < k1) { int q0 = 0, q1 = 0;
                    q0 = __builtin_amdgcn_cvt_pk_fp8_f32(__builtin_amdgcn_fmed3f(r[0], -448.f, 448.f), __builtin_amdgcn_fmed3f(r[1], -448.f, 448.f), q0, false);
                    q0 = __builtin_amdgcn_cvt_pk_fp8_f32(__builtin_amdgcn_fmed3f(r[2], -448.f, 448.f), __builtin_amdgcn_fmed3f(r[3], -448.f, 448.f), q0, true);
                    q1 = __builtin_amdgcn_cvt_pk_fp8_f32(__builtin_amdgcn_fmed3f(r[4], -448.f, 448.f), __builtin_amdgcn_fmed3f(r[5], -448.f, 448.f), q1, false);
                    q1 = __builtin_amdgcn_cvt_pk_fp8_f32(__builtin_amdgcn_fmed3f(r[6], -448.f, 448.f), __builtin_amdgcn_fmed3f(r[7], -448.f, 448.f), q1, true);
                    *(u32x2*)(rowp + col0) = (u32x2){(unsigned)q0, (unsigned)q1};
                } else { u32x4 w; w.x = cvt_pk_bf16(r[0], r[1]); w.y = cvt_pk_bf16(r[2], r[3]); w.z = cvt_pk_bf16(r[4], r[5]); w.w = cvt_pk_bf16(r[6], r[7]);
                    *(u32x4*)(rowp + k1 + 2 * (col0 - k1)) = w; } }
    }
};
struct EpiPleGate {
    static constexpr bool PERM = true, AFTER_DRAIN = false;
    const bf16_t* hb; bf16_t* out; const bf16_t* pe; const unsigned long long* ss; const float* rspe; int ldc; int pad;
    __device__ __forceinline__ void operator()(const f32x4 (&acc)[2][2][4][2], const Unit& u, int wr, int wc, int fr_in, int fq_in) const {
        int fr = fr_in, fq = fq_in; asm volatile("" : "+v"(fr), "+v"(fq));
        const int row0 = u.pm * BM + wr * 64 + fr, col0 = u.pn * BM + wc * 32 + 8 * fq;
        float rs[2][4];
#pragma unroll
        for (int ai = 0; ai < 2; ++ai)
#pragma unroll
            for (int m = 0; m < 4; ++m) rs[ai][m] = (-1.4426950408889634f / 128.0f) * ss_to_rstd(ss[row0 + ai * HALF + m * 16], 1.0f / 4096.0f, 1e-6f);
#pragma unroll
        for (int ai = 0; ai < 2; ++ai)
#pragma unroll
        for (int mh = 0; mh < 2; ++mh) {
            u32x4 bw[2][2], pv[2][2]; float rp[2];
#pragma unroll
            for (int mm = 0; mm < 2; ++mm) { const int m = mh * 2 + mm; const size_t off = (size_t)(row0 + ai * HALF + m * 16) * ldc + col0;
#pragma unroll
                for (int bj = 0; bj < 2; ++bj) { bw[mm][bj] = *(const u32x4*)(hb + off + bj * HALF); pv[mm][bj] = *(const u32x4*)(pe + off + bj * HALF); }
                rp[mm] = rspe[row0 + ai * HALF + m * 16]; }
#pragma unroll
            for (int mm = 0; mm < 2; ++mm) { const int m = mh * 2 + mm; const size_t off = (size_t)(row0 + ai * HALF + m * 16) * ldc + col0;
#pragma unroll
                for (int bj = 0; bj < 2; ++bj) { float o[8];
#pragma unroll
                    for (int n = 0; n < 2; ++n) { const f32x4 a = acc[ai][bj][m][n]; const unsigned h0 = bw[mm][bj][2 * n], h1 = bw[mm][bj][2 * n + 1], w0 = pv[mm][bj][2 * n], w1 = pv[mm][bj][2 * n + 1];
                        o[4 * n + 0] = __uint_as_float(h0 << 16) + __builtin_amdgcn_rcpf(1.0f + __builtin_amdgcn_exp2f(rs[ai][m] * a[0])) * (rp[mm] * __uint_as_float(w0 << 16));
                        o[4 * n + 1] = __uint_as_float(h0 & 0xffff0000u) + __builtin_amdgcn_rcpf(1.0f + __builtin_amdgcn_exp2f(rs[ai][m] * a[1])) * (rp[mm] * __uint_as_float(w0 & 0xffff0000u));
                        o[4 * n + 2] = __uint_as_float(h1 << 16) + __builtin_amdgcn_rcpf(1.0f + __builtin_amdgcn_exp2f(rs[ai][m] * a[2])) * (rp[mm] * __uint_as_float(w1 << 16));
                        o[4 * n + 3] = __uint_as_float(h1 & 0xffff0000u) + __builtin_amdgcn_rcpf(1.0f + __builtin_amdgcn_exp2f(rs[ai][m] * a[3])) * (rp[mm] * __uint_as_float(w1 & 0xffff0000u)); }
                    u32x4 w; w.x = cvt_pk_bf16(o[0], o[1]); w.y = cvt_pk_bf16(o[2], o[3]); w.z = cvt_pk_bf16(o[4], o[5]); w.w = cvt_pk_bf16(o[6], o[7]);
                    *(u32x4*)(out + off + bj * HALF) = w; } }
            asm volatile("" ::: "memory");
        }
    }
};

template <class...> using pg8_void_t = void;
template <class E, class = void> struct epi_midk { static constexpr bool value = false; };
template <class E> struct epi_midk<E, pg8_void_t<decltype(E::MIDK)>> { static constexpr bool value = E::MIDK; };
struct EpiResMid : EpiRes<true, true, false> {
    static constexpr bool MIDK = true;
    const float* rat; const float* rsr;
    __device__ __forceinline__ void pre_rows(const Unit& u, int wr, int fr_in, float (&rat_)[2][4], float (&rs_)[2][4]) const {
        int fr = fr_in; asm volatile("" : "+v"(fr));
#pragma unroll
        for (int ai = 0; ai < 2; ++ai)
#pragma unroll
            for (int m = 0; m < 4; ++m) { const int row = u.pm * BM + wr * 64 + fr + ai * HALF + m * 16; rat_[ai][m] = rat[row]; rs_[ai][m] = rsr[row]; }
    }
};
template <class Epi, class Sched, bool ALIGN_EPI = false, bool SP2 = false, bool REVK = false>
__device__ __forceinline__ void gemm_phase(PG8_LAS unsigned char* lds, const Gemm g, const Sched& S, const Epi& E) {
    int tid_ = threadIdx.x; asm volatile("" : "+v"(tid_));
    const int tid = tid_, wid = __builtin_amdgcn_readfirstlane(tid >> 6), lane = tid & 63, wr = wid >> 2, wc = wid & 3, fr = lane & 15, fq = lane >> 4;
    const int K = g.K, nt = K / BK;
    const __amdgpu_buffer_rsrc_t rA = __builtin_amdgcn_make_buffer_rsrc((void*)g.A, 0, g.M * K * 2, 0x00020000), rB = __builtin_amdgcn_make_buffer_rsrc((void*)g.Bt, 0, g.N * K * 2, 0x00020000);
    int voffA[2], voffB[2];
#pragma unroll
    for (int i = 0; i < 2; ++i) { int R, C; stage_rc(tid * 16 + i * 8192, R, C); const int Rb = Epi::PERM ? ((R & ~31) + perm32(R & 31)) : R;
        voffA[i] = (R * K + C) * 2; voffB[i] = (Rb * K + C) * 2; }
    const int kstep = REVK ? -(BK * 2) : BK * 2, hstep = HALF * K * 2, tstep = 2 * hstep, k0off = REVK ? (nt - 1) * BK * 2 : 0;
    const unsigned ldsw = (unsigned)wid * 1024u;
    const int aoff = lds_byte(wr * 64 + fr, fq * 8), boff = lds_byte(wc * 32 + fr, fq * 8);
#define PG8_SA(b, h) (((b) * 2 + (h)) * HTB)
#define PG8_SB(b, h) ((4 + (b) * 2 + (h)) * HTB)
#define PG8_STAGE(bufoff, rsrc, soff, voff) do { _Pragma("unroll") for (int _i = 0; _i < 2; ++_i) \
        __builtin_amdgcn_raw_ptr_buffer_load_lds(rsrc, (PG8_LAS unsigned*)(lds + (bufoff) + ldsw + _i * 8192), 16, (voff)[_i], (soff), 0, 0); } while (0)
#define PG8_LDA(dst, b, h) do { _Pragma("unroll") for (int m = 0; m < 4; ++m) _Pragma("unroll") for (int k = 0; k < 2; ++k) dst[m][k] = *(const PG8_LAS bf16x8*)(lds + PG8_SA(b, h) + aoff + m * 2048 + k * 1024); } while (0)
#define PG8_LDB(dst, b, h) do { _Pragma("unroll") for (int n = 0; n < 2; ++n) _Pragma("unroll") for (int k = 0; k < 2; ++k) dst[n][k] = *(const PG8_LAS bf16x8*)(lds + PG8_SB(b, h) + boff + n * 2048 + k * 1024); } while (0)
#define PG8_MMA(ai, bj, At, Bt) do { __builtin_amdgcn_s_setprio(1); _Pragma("unroll") for (int m = 0; m < 4; ++m) _Pragma("unroll") for (int n = 0; n < 2; ++n) _Pragma("unroll") for (int k = 0; k < 2; ++k) \
        acc[ai][bj][m][n] = __builtin_amdgcn_mfma_f32_16x16x32_bf16(Bt[n][k], At[m][k], acc[ai][bj][m][n], 0, 0, 0); __builtin_amdgcn_s_setprio(0); } while (0)
#define PG8_WAIT_V(n) asm volatile("s_waitcnt vmcnt(" #n ")" ::: "memory")
#define PG8_WAIT_L(n) asm volatile("s_waitcnt lgkmcnt(" #n ")" ::: "memory")
#define PG8_BAR __builtin_amdgcn_s_barrier()
#define PG8_SCHED __builtin_amdgcn_sched_barrier(0)
    Unit cur, nxt; int ui = 0;
    if (!S.next(0, cur)) return;
    f32x4 acc[2][2][4][2];
#pragma unroll
    for (int a = 0; a < 2; ++a)
#pragma unroll
        for (int b = 0; b < 2; ++b)
#pragma unroll
            for (int m = 0; m < 4; ++m)
#pragma unroll
                for (int n = 0; n < 2; ++n) acc[a][b][m][n] = (f32x4){0.f, 0.f, 0.f, 0.f};
    bf16x8 At[4][2], B0[2][2], B1[2][2];
    int cA = cur.pm * tstep + k0off, cB = cur.pn * tstep + k0off;
    S.a_ready(cur);
    if constexpr (SP2) {
        PG8_STAGE(PG8_SB(0, 0), rB, cB, voffB); PG8_STAGE(PG8_SB(0, 1), rB, cB + hstep, voffB); PG8_STAGE(PG8_SA(0, 0), rA, cA, voffA); PG8_STAGE(PG8_SA(0, 1), rA, cA + hstep, voffA);
        if (wr == 1) PG8_BAR;
        PG8_WAIT_V(2); PG8_BAR;
        PG8_STAGE(PG8_SB(1, 0), rB, cB + kstep, voffB); PG8_STAGE(PG8_SA(1, 0), rA, cA + kstep, voffA); PG8_STAGE(PG8_SB(1, 1), rB, cB + hstep + kstep, voffB);
        PG8_WAIT_V(6); PG8_BAR;
    } else {
        PG8_STAGE(PG8_SB(0, 0), rB, cB, voffB); PG8_STAGE(PG8_SA(0, 0), rA, cA, voffA); PG8_STAGE(PG8_SB(0, 1), rB, cB + hstep, voffB); PG8_STAGE(PG8_SA(0, 1), rA, cA + hstep, voffA);
        if (wr == 1) PG8_BAR;
        PG8_WAIT_V(4); PG8_BAR;
        PG8_STAGE(PG8_SB(1, 0), rB, cB + kstep, voffB); PG8_STAGE(PG8_SA(1, 0), rA, cA + kstep, voffA); PG8_STAGE(PG8_SB(1, 1), rB, cB + hstep + kstep, voffB);
        PG8_WAIT_V(6); PG8_BAR;
    }
    for (;;) {
        const bool has_next = S.next(ui + 1, nxt);
        const int nA = has_next ? nxt.pm * tstep + k0off : cA, nB = has_next ? nxt.pn * tstep + k0off : cB;
        constexpr bool MIDK = epi_midk<Epi>::value;
        float mk_rat[2][4], mk_rs[2][4];
        if constexpr (MIDK) E.pre_rows(cur, wr, fr, mk_rat, mk_rs);
        for (int hf = 0; hf < (MIDK ? 2 : 1); ++hf) {
        const int tb = MIDK ? hf * (nt / 2) : 0, te = MIDK ? tb + nt / 2 : nt;
        for (int t = tb; t < te; t += 2) {
            const bool last = (t == nt - 2);
            const int a1 = cA + (t + 1) * kstep;
            const int a2 = last ? nA : cA + (t + 2) * kstep, b2 = last ? nB : cB + (t + 2) * kstep;
            const int a3 = a2 + kstep, b3 = b2 + kstep;
            if (last && has_next) S.a_ready(nxt);
            if constexpr (SP2) {
            PG8_LDB(B0, 0, 0); PG8_LDB(B1, 0, 1); PG8_SCHED; PG8_LDA(At, 0, 0); PG8_STAGE(PG8_SA(1, 1), rA, a1 + hstep, voffA);
            PG8_WAIT_V(8); PG8_WAIT_L(0); PG8_BAR; PG8_MMA(0, 0, At, B0); PG8_MMA(0, 1, At, B1); PG8_BAR; PG8_SCHED;
            PG8_LDA(At, 0, 1); PG8_STAGE(PG8_SB(0, 0), rB, b2, voffB); PG8_STAGE(PG8_SB(0, 1), rB, b2 + hstep, voffB); PG8_STAGE(PG8_SA(0, 0), rA, a2, voffA);
            PG8_WAIT_V(8); PG8_WAIT_L(0); PG8_BAR; PG8_MMA(1, 0, At, B0); PG8_MMA(1, 1, At, B1); PG8_BAR; PG8_SCHED;
            PG8_LDB(B0, 1, 0); PG8_LDB(B1, 1, 1); PG8_SCHED; PG8_LDA(At, 1, 0); PG8_STAGE(PG8_SA(0, 1), rA, a2 + hstep, voffA);
            PG8_WAIT_V(8); PG8_WAIT_L(0); PG8_BAR; PG8_MMA(0, 0, At, B0); PG8_MMA(0, 1, At, B1); PG8_BAR; PG8_SCHED;
            PG8_LDA(At, 1, 1); PG8_STAGE(PG8_SB(1, 0), rB, b3, voffB); PG8_STAGE(PG8_SB(1, 1), rB, b3 + hstep, voffB); PG8_STAGE(PG8_SA(1, 0), rA, a3, voffA);
            PG8_WAIT_V(8); PG8_WAIT_L(0); PG8_BAR; PG8_MMA(1, 0, At, B0); PG8_MMA(1, 1, At, B1); PG8_BAR; PG8_SCHED;
            } else {
            PG8_LDB(B0, 0, 0); PG8_SCHED; PG8_LDA(At, 0, 0); PG8_STAGE(PG8_SA(1, 1), rA, a1 + hstep, voffA);
            PG8_WAIT_L(8); PG8_BAR; PG8_WAIT_L(0); PG8_MMA(0, 0, At, B0); PG8_BAR; PG8_SCHED;
            PG8_LDB(B1, 0, 1); PG8_STAGE(PG8_SB(0, 0), rB, b2, voffB);
            PG8_BAR; PG8_WAIT_L(0); PG8_MMA(0, 1, At, B1); PG8_BAR;
            PG8_LDA(At, 0, 1); PG8_STAGE(PG8_SA(0, 0), rA, a2, voffA);
            PG8_BAR; PG8_WAIT_L(0); PG8_MMA(1, 0, At, B0); PG8_BAR; PG8_SCHED;
            PG8_STAGE(PG8_SB(0, 1), rB, b2 + hstep, voffB);
            PG8_WAIT_V(6); PG8_BAR; PG8_MMA(1, 1, At, B1); PG8_BAR;
            PG8_LDB(B0, 1, 0); PG8_SCHED; PG8_LDA(At, 1, 0); PG8_STAGE(PG8_SA(0, 1), rA, a2 + hstep, voffA);
            PG8_WAIT_L(8); PG8_BAR; PG8_WAIT_L(0); PG8_MMA(0, 0, At, B0); PG8_BAR; PG8_SCHED;
            PG8_LDB(B1, 1, 1); PG8_STAGE(PG8_SB(1, 0), rB, b3, voffB);
            PG8_BAR; PG8_WAIT_L(0); PG8_MMA(0, 1, At, B1); PG8_BAR;
            PG8_LDA(At, 1, 1); PG8_STAGE(PG8_SA(1, 0), rA, a3, voffA);
            PG8_BAR; PG8_WAIT_L(0); PG8_MMA(1, 0, At, B0); PG8_BAR; PG8_SCHED;
            PG8_STAGE(PG8_SB(1, 1), rB, b3 + hstep, voffB);
            PG8_WAIT_V(6); PG8_BAR; PG8_MMA(1, 1, At, B1); PG8_BAR;
            }
        }
        if constexpr (MIDK) { if (hf == 0) {
#pragma unroll
            for (int a = 0; a < 2; ++a)
#pragma unroll
                for (int b = 0; b < 2; ++b)
#pragma unroll
                    for (int m = 0; m < 4; ++m)
#pragma unroll
                        for (int n = 0; n < 2; ++n) acc[a][b][m][n] *= mk_rat[a][m]; } }
        }
        if constexpr (ALIGN_EPI) { if (wr == 0) PG8_BAR; }
        if constexpr (!Epi::AFTER_DRAIN) { if constexpr (MIDK) E(acc, cur, wr, wc, fr, fq, mk_rs); else E(acc, cur, wr, wc, fr, fq); S.done(cur); }
        if (!has_next) break;
#pragma unroll
        for (int a = 0; a < 2; ++a)
#pragma unroll
            for (int b = 0; b < 2; ++b)
#pragma unroll
                for (int m = 0; m < 4; ++m)
#pragma unroll
                    for (int n = 0; n < 2; ++n) acc[a][b][m][n] = (f32x4){0.f, 0.f, 0.f, 0.f};
        cur = nxt; cA = nA; cB = nB; ++ui;
        if constexpr (ALIGN_EPI) { if (wr == 1) PG8_BAR; }
    }
    PG8_WAIT_V(0);
    if constexpr (!ALIGN_EPI) { if (wr == 0) PG8_BAR; }
    PG8_BAR;
#undef PG8_SA
#undef PG8_SB
#undef PG8_STAGE
#undef PG8_LDA
#undef PG8_LDB
#undef PG8_MMA
#undef PG8_WAIT_V
#undef PG8_WAIT_L
#undef PG8_BAR
#undef PG8_SCHED
}

typedef int v8i __attribute__((ext_vector_type(8)));
typedef int v4i __attribute__((ext_vector_type(4)));
__device__ __forceinline__ v8i cat8(v4i lo, v4i hi) { return __builtin_shufflevector(lo, hi, 0, 1, 2, 3, 4, 5, 6, 7); }
__device__ __forceinline__ bf16x8 lo8(v8i v) { return __builtin_bit_cast(bf16x8, (v4i)__builtin_shufflevector(v, v, 0, 1, 2, 3)); }
__device__ __forceinline__ bf16x8 hi8(v8i v) { return __builtin_bit_cast(bf16x8, (v4i)__builtin_shufflevector(v, v, 4, 5, 6, 7)); }
template <class Epi, class Sched, int MIXN8 = 0>
__device__ __forceinline__ void gemm_phase_fp8(PG8_LAS unsigned char* lds, const Gemm g, const Sched& S, const Epi& E) {
    int tid_ = threadIdx.x; asm volatile("" : "+v"(tid_));
    const int tid = tid_, wid = __builtin_amdgcn_readfirstlane(tid >> 6), lane = tid & 63, wr = wid >> 2, wc = wid & 3, fr = lane & 15, fq = lane >> 4;
    const int K = g.K, nt = K / 128;
    const __amdgpu_buffer_rsrc_t rA = __builtin_amdgcn_make_buffer_rsrc((void*)g.A, 0, g.M * K, 0x00020000), rB = __builtin_amdgcn_make_buffer_rsrc((void*)g.Bt, 0, g.N * K, 0x00020000);
    int voffA[2], voffB[2];
#pragma unroll
    for (int i = 0; i < 2; ++i) { int R, C; stage_rc(tid * 16 + i * 8192, R, C); const int Rb = Epi::PERM ? ((R & ~31) + perm32(R & 31)) : R;
        voffA[i] = R * K + C * 2; voffB[i] = Rb * K + C * 2; }
    const int kstep = 128, hstep = HALF * K, tstep = 2 * hstep;
    const unsigned ldsw = (unsigned)wid * 1024u;
    const int aoff = lds_byte(wr * 64 + fr, fq * 8), boff = lds_byte(wc * 32 + fr, fq * 8);
#define PG8_SA(b, h) (((b) * 2 + (h)) * HTB)
#define PG8_SB(b, h) ((4 + (b) * 2 + (h)) * HTB)
#define PG8_STAGE(bufoff, rsrc, soff, voff) do { _Pragma("unroll") for (int _i = 0; _i < 2; ++_i) \
        __builtin_amdgcn_raw_ptr_buffer_load_lds(rsrc, (PG8_LAS unsigned*)(lds + (bufoff) + ldsw + _i * 8192), 16, (voff)[_i], (soff), 0, 0); } while (0)
#define PG8_LDA(dst, b, h) do { _Pragma("unroll") for (int m = 0; m < 4; ++m) dst[m] = cat8(*(const PG8_LAS v4i*)(lds + PG8_SA(b, h) + aoff + m * 2048), *(const PG8_LAS v4i*)(lds + PG8_SA(b, h) + aoff + m * 2048 + 1024)); } while (0)
#define PG8_LDB(dst, b, h) do { _Pragma("unroll") for (int n = 0; n < 2; ++n) dst[n] = cat8(*(const PG8_LAS v4i*)(lds + PG8_SB(b, h) + boff + n * 2048), *(const PG8_LAS v4i*)(lds + PG8_SB(b, h) + boff + n * 2048 + 1024)); } while (0)
#define PG8_MMA8(ai, bj, At, Bt) do { __builtin_amdgcn_s_setprio(1); _Pragma("unroll") for (int m = 0; m < 4; ++m) _Pragma("unroll") for (int n = 0; n < 2; ++n) \
        acc[ai][bj][m][n] = __builtin_amdgcn_mfma_scale_f32_16x16x128_f8f6f4(Bt[n], At[m], acc[ai][bj][m][n], 0, 0, 0, 0x7f7f7f7f, 0, 0x7f7f7f7f); __builtin_amdgcn_s_setprio(0); } while (0)
#define PG8_MMA16(ai, bj, At, Bt) do { __builtin_amdgcn_s_setprio(1); _Pragma("unroll") for (int m = 0; m < 4; ++m) _Pragma("unroll") for (int n = 0; n < 2; ++n) { \
        acc[ai][bj][m][n] = __builtin_amdgcn_mfma_f32_16x16x32_bf16(lo8(Bt[n]), lo8(At[m]), acc[ai][bj][m][n], 0, 0, 0); \
        acc[ai][bj][m][n] = __builtin_amdgcn_mfma_f32_16x16x32_bf16(hi8(Bt[n]), hi8(At[m]), acc[ai][bj][m][n], 0, 0, 0); } __builtin_amdgcn_s_setprio(0); } while (0)
#define PG8_WAIT_V(n) asm volatile("s_waitcnt vmcnt(" #n ")" ::: "memory")
#define PG8_WAIT_L(n) asm volatile("s_waitcnt lgkmcnt(" #n ")" ::: "memory")
#define PG8_BAR __builtin_amdgcn_s_barrier()
#define PG8_SCHED __builtin_amdgcn_sched_barrier(0)
    Unit cur, nxt; int ui = 0;
    if (!S.next(0, cur)) return;
    f32x4 acc[2][2][4][2];
#pragma unroll
    for (int a = 0; a < 2; ++a)
#pragma unroll
        for (int b = 0; b < 2; ++b)
#pragma unroll
            for (int m = 0; m < 4; ++m)
#pragma unroll
                for (int n = 0; n < 2; ++n) acc[a][b][m][n] = (f32x4){0.f, 0.f, 0.f, 0.f};
    v8i At[4], B0[2], B1[2];
    int cA = cur.pm * tstep, cB = cur.pn * tstep;
    PG8_STAGE(PG8_SB(0, 0), rB, cB, voffB); PG8_STAGE(PG8_SB(0, 1), rB, cB + hstep, voffB); PG8_STAGE(PG8_SA(0, 0), rA, cA, voffA); PG8_STAGE(PG8_SA(0, 1), rA, cA + hstep, voffA);
    if (wr == 1) PG8_BAR;
    PG8_WAIT_V(2); PG8_BAR;
    PG8_STAGE(PG8_SB(1, 0), rB, cB + kstep, voffB); PG8_STAGE(PG8_SA(1, 0), rA, cA + kstep, voffA); PG8_STAGE(PG8_SB(1, 1), rB, cB + hstep + kstep, voffB);
    PG8_WAIT_V(6); PG8_BAR;
    for (;;) {
        const bool has_next = S.next(ui + 1, nxt);
        const int nA = has_next ? nxt.pm * tstep : cA, nB = has_next ? nxt.pn * tstep : cB;
#define PG8_KBODY(MM) { \
            const bool last = (t == nt - 2); \
            const int a1 = cA + (t + 1) * kstep; \
            const int a2 = last ? nA : cA + (t + 2) * kstep, b2 = last ? nB : cB + (t + 2) * kstep; \
            const int a3 = a2 + kstep, b3 = b2 + kstep; \
            PG8_LDB(B0, 0, 0); PG8_LDB(B1, 0, 1); PG8_SCHED; PG8_LDA(At, 0, 0); PG8_STAGE(PG8_SA(1, 1), rA, a1 + hstep, voffA); \
            PG8_WAIT_V(8); PG8_WAIT_L(0); PG8_BAR; MM(0, 0, At, B0); MM(0, 1, At, B1); PG8_BAR; PG8_SCHED; \
            PG8_LDA(At, 0, 1); PG8_STAGE(PG8_SB(0, 0), rB, b2, voffB); PG8_STAGE(PG8_SB(0, 1), rB, b2 + hstep, voffB); PG8_STAGE(PG8_SA(0, 0), rA, a2, voffA); \
            PG8_WAIT_V(8); PG8_WAIT_L(0); PG8_BAR; MM(1, 0, At, B0); MM(1, 1, At, B1); PG8_BAR; PG8_SCHED; \
            PG8_LDB(B0, 1, 0); PG8_LDB(B1, 1, 1); PG8_SCHED; PG8_LDA(At, 1, 0); PG8_STAGE(PG8_SA(0, 1), rA, a2 + hstep, voffA); \
            PG8_WAIT_V(8); PG8_WAIT_L(0); PG8_BAR; MM(0, 0, At, B0); MM(0, 1, At, B1); PG8_BAR; PG8_SCHED; \
            PG8_LDA(At, 1, 1); PG8_STAGE(PG8_SB(1, 0), rB, b3, voffB); PG8_STAGE(PG8_SB(1, 1), rB, b3 + hstep, voffB); PG8_STAGE(PG8_SA(1, 0), rA, a3, voffA); \
            PG8_WAIT_V(8); PG8_WAIT_L(0); PG8_BAR; MM(1, 0, At, B0); MM(1, 1, At, B1); PG8_BAR; PG8_SCHED; }
        if constexpr (MIXN8 > 0) {
            for (int t = 0; t < MIXN8; t += 2) PG8_KBODY(PG8_MMA8)
            for (int t = MIXN8; t < nt; t += 2) PG8_KBODY(PG8_MMA16)
        } else {
            for (int t = 0; t < nt; t += 2) PG8_KBODY(PG8_MMA8)
        }
#undef PG8_KBODY
        if (wr == 0) PG8_BAR;
        E(acc, cur, wr, wc, fr, fq);
        if (!has_next) break;
#pragma unroll
        for (int a = 0; a < 2; ++a)
#pragma unroll
            for (int b = 0; b < 2; ++b)
#pragma unroll
                for (int m = 0; m < 4; ++m)
#pragma unroll
                    for (int n = 0; n < 2; ++n) acc[a][b][m][n] = (f32x4){0.f, 0.f, 0.f, 0.f};
        cur = nxt; cA = nA; cB = nB; ++ui;
        if (wr == 1) PG8_BAR;
    }
    PG8_WAIT_V(0);
    PG8_BAR;
#undef PG8_SA
#undef PG8_SB
#undef PG8_STAGE
#undef PG8_LDA
#undef PG8_LDB
#undef PG8_MMA8
#undef PG8_MMA16
#undef PG8_WAIT_V
#undef PG8_WAIT_L
#undef PG8_BAR
#undef PG8_SCHED
}

template <class Epi, class Sched>
__device__ __forceinline__ void gemm_phase_i8(PG8_LAS unsigned char* lds, const Gemm g, const Sched& S, const Epi& E) {
    int tid_ = threadIdx.x; asm volatile("" : "+v"(tid_));
    const int tid = tid_, wid = __builtin_amdgcn_readfirstlane(tid >> 6), lane = tid & 63, wr = wid >> 2, wc = wid & 3, fr = lane & 15, fq = lane >> 4;
    const int K = g.K, nt = K / 128;
    const __amdgpu_buffer_rsrc_t rA = __builtin_amdgcn_make_buffer_rsrc((void*)g.A, 0, g.M * K, 0x00020000), rB = __builtin_amdgcn_make_buffer_rsrc((void*)g.Bt, 0, g.N * K, 0x00020000);
    int voffA[2], voffB[2];
#pragma unroll
    for (int i = 0; i < 2; ++i) { int R, C; stage_rc(tid * 16 + i * 8192, R, C); const int Rb = Epi::PERM ? ((R & ~31) + perm32(R & 31)) : R;
        voffA[i] = R * K + C * 2; voffB[i] = Rb * K + C * 2; }
    const int kstep = 128, hstep = HALF * K, tstep = 2 * hstep;
    const unsigned ldsw = (unsigned)wid * 1024u;
    const int aoff = lds_byte(wr * 64 + fr, fq * 8), boff = lds_byte(wc * 32 + fr, fq * 8);
#define PG8_SA(b, h) (((b) * 2 + (h)) * HTB)
#define PG8_SB(b, h) ((4 + (b) * 2 + (h)) * HTB)
#define PG8_STAGE(bufoff, rsrc, soff, voff) do { _Pragma("unroll") for (int _i = 0; _i < 2; ++_i) \
        __builtin_amdgcn_raw_ptr_buffer_load_lds(rsrc, (PG8_LAS unsigned*)(lds + (bufoff) + ldsw + _i * 8192), 16, (voff)[_i], (soff), 0, 0); } while (0)
#define PG8_LDA(dst, b, h) do { _Pragma("unroll") for (int m = 0; m < 4; ++m) dst[m] = cat8(*(const PG8_LAS v4i*)(lds + PG8_SA(b, h) + aoff + m * 2048), *(const PG8_LAS v4i*)(lds + PG8_SA(b, h) + aoff + m * 2048 + 1024)); } while (0)
#define PG8_LDB(dst, b, h) do { _Pragma("unroll") for (int n = 0; n < 2; ++n) dst[n] = cat8(*(const PG8_LAS v4i*)(lds + PG8_SB(b, h) + boff + n * 2048), *(const PG8_LAS v4i*)(lds + PG8_SB(b, h) + boff + n * 2048 + 1024)); } while (0)
#define PG8_MMA8(ai, bj, At, Bt) do { __builtin_amdgcn_s_setprio(1); _Pragma("unroll") for (int m = 0; m < 4; ++m) _Pragma("unroll") for (int n = 0; n < 2; ++n) { \
        acc[ai][bj][m][n] = __builtin_amdgcn_mfma_i32_16x16x64_i8((v4i)__builtin_shufflevector(Bt[n], Bt[n], 0, 1, 2, 3), (v4i)__builtin_shufflevector(At[m], At[m], 0, 1, 2, 3), acc[ai][bj][m][n], 0, 0, 0); \
        acc[ai][bj][m][n] = __builtin_amdgcn_mfma_i32_16x16x64_i8((v4i)__builtin_shufflevector(Bt[n], Bt[n], 4, 5, 6, 7), (v4i)__builtin_shufflevector(At[m], At[m], 4, 5, 6, 7), acc[ai][bj][m][n], 0, 0, 0); } __builtin_amdgcn_s_setprio(0); } while (0)
#define PG8_WAIT_V(n) asm volatile("s_waitcnt vmcnt(" #n ")" ::: "memory")
#define PG8_WAIT_L(n) asm volatile("s_waitcnt lgkmcnt(" #n ")" ::: "memory")
#define PG8_BAR __builtin_amdgcn_s_barrier()
#define PG8_SCHED __builtin_amdgcn_sched_barrier(0)
    Unit cur, nxt; int ui = 0;
    if (!S.next(0, cur)) return;
    v4i acc[2][2][4][2];
#pragma unroll
    for (int a = 0; a < 2; ++a)
#pragma unroll
        for (int b = 0; b < 2; ++b)
#pragma unroll
            for (int m = 0; m < 4; ++m)
#pragma unroll
                for (int n = 0; n < 2; ++n) acc[a][b][m][n] = (v4i){0, 0, 0, 0};
    v8i At[4], B0[2], B1[2];
    int cA = cur.pm * tstep, cB = cur.pn * tstep;
    PG8_STAGE(PG8_SB(0, 0), rB, cB, voffB); PG8_STAGE(PG8_SB(0, 1), rB, cB + hstep, voffB); PG8_STAGE(PG8_SA(0, 0), rA, cA, voffA); PG8_STAGE(PG8_SA(0, 1), rA, cA + hstep, voffA);
    if (wr == 1) PG8_BAR;
    PG8_WAIT_V(2); PG8_BAR;
    PG8_STAGE(PG8_SB(1, 0), rB, cB + kstep, voffB); PG8_STAGE(PG8_SA(1, 0), rA, cA + kstep, voffA); PG8_STAGE(PG8_SB(1, 1), rB, cB + hstep + kstep, voffB);
    PG8_WAIT_V(6); PG8_BAR;
    for (;;) {
        const bool has_next = S.next(ui + 1, nxt);
        const int nA = has_next ? nxt.pm * tstep : cA, nB = has_next ? nxt.pn * tstep : cB;
        const typename Epi::Pre pre = E.pre(cur, wr, wc, fr, fq);
#define PG8_KBODY(MM) { \
            const bool last = (t == nt - 2); \
            const int a1 = cA + (t + 1) * kstep; \
            const int a2 = last ? nA : cA + (t + 2) * kstep, b2 = last ? nB : cB + (t + 2) * kstep; \
            const int a3 = a2 + kstep, b3 = b2 + kstep; \
            PG8_LDB(B0, 0, 0); PG8_LDB(B1, 0, 1); PG8_SCHED; PG8_LDA(At, 0, 0); PG8_STAGE(PG8_SA(1, 1), rA, a1 + hstep, voffA); \
            PG8_WAIT_V(8); PG8_WAIT_L(0); PG8_BAR; MM(0, 0, At, B0); MM(0, 1, At, B1); PG8_BAR; PG8_SCHED; \
            PG8_LDA(At, 0, 1); PG8_STAGE(PG8_SB(0, 0), rB, b2, voffB); PG8_STAGE(PG8_SB(0, 1), rB, b2 + hstep, voffB); PG8_STAGE(PG8_SA(0, 0), rA, a2, voffA); \
            PG8_WAIT_V(8); PG8_WAIT_L(0); PG8_BAR; MM(1, 0, At, B0); MM(1, 1, At, B1); PG8_BAR; PG8_SCHED; \
            PG8_LDB(B0, 1, 0); PG8_LDB(B1, 1, 1); PG8_SCHED; PG8_LDA(At, 1, 0); PG8_STAGE(PG8_SA(0, 1), rA, a2 + hstep, voffA); \
            PG8_WAIT_V(8); PG8_WAIT_L(0); PG8_BAR; MM(0, 0, At, B0); MM(0, 1, At, B1); PG8_BAR; PG8_SCHED; \
            PG8_LDA(At, 1, 1); PG8_STAGE(PG8_SB(1, 0), rB, b3, voffB); PG8_STAGE(PG8_SB(1, 1), rB, b3 + hstep, voffB); PG8_STAGE(PG8_SA(1, 0), rA, a3, voffA); \
            PG8_WAIT_V(8); PG8_WAIT_L(0); PG8_BAR; MM(1, 0, At, B0); MM(1, 1, At, B1); PG8_BAR; PG8_SCHED; }
        for (int t = 0; t < nt; t += 2) PG8_KBODY(PG8_MMA8)
#undef PG8_KBODY
        if (wr == 0) PG8_BAR;
        E(acc, cur, wr, wc, fr, fq, pre);
        if (!has_next) break;
#pragma unroll
        for (int a = 0; a < 2; ++a)
#pragma unroll
            for (int b = 0; b < 2; ++b)
#pragma unroll
                for (int m = 0; m < 4; ++m)
#pragma unroll
                    for (int n = 0; n < 2; ++n) acc[a][b][m][n] = (v4i){0, 0, 0, 0};
        cur = nxt; cA = nA; cB = nB; ++ui;
        if (wr == 1) PG8_BAR;
    }
    PG8_WAIT_V(0);
    PG8_BAR;
#undef PG8_SA
#undef PG8_SB
#undef PG8_STAGE
#undef PG8_LDA
#undef PG8_LDB
#undef PG8_MMA8
#undef PG8_WAIT_V
#undef PG8_WAIT_L
#undef PG8_BAR
#undef PG8_SCHED
}
}

constexpr int NB = 4, SEQ = 4096, DM = 4096, NH = 16, HD = 128, DA = 2048, DR = 2048, DIN = 10240, DFF = 11008, NGU = 2 * DFF, PLE = 256;
constexpr int M = NB * SEQ;
constexpr int COL_Q = 0, COL_K = 2048, COL_V = 4096, COL_XR = 6144, COL_GR = 8192;
constexpr float NORM_EPS = 1e-6f;
constexpr float QSCALE = 0.08838834764831845f * 1.4426950408889634f;
constexpr int DN8 = 36, DK1 = DN8 * 128, DK2 = DFF - DK1, DPITCH = DK1 + 2 * DK2;
constexpr float HID_SCALE = 16.0f, WDN_SCALE = 64.0f;
constexpr float C2_EXIT = 152.0f;

constexpr size_t MiB = 1u << 20;
constexpr int NI8 = 2 * DA;
constexpr size_t WS_CTL = 0;
constexpr size_t WS_WIN = 1 * MiB, WS_WOUT = 81 * MiB, WS_WGU = 113 * MiB, WS_WDN = 285 * MiB, WS_WPG = 371 * MiB, WS_WPP = 403 * MiB, WS_WRA = 405 * MiB, WS_WRX = WS_WRA + MiB / 2;
constexpr size_t WS_PB = 406 * MiB;
constexpr size_t WS_A1 = 414 * MiB;
constexpr size_t WS_A2 = 542 * MiB;
constexpr size_t WS_HID = 414 * MiB;
constexpr size_t WS_HB = 758 * MiB;
constexpr size_t WS_SA = 64 * 1024;
constexpr size_t WS_SB = 768 * 1024;
constexpr size_t WS_SBIN = 896 * 1024;
constexpr size_t WS_RSXQ = 944 * 1024;
constexpr size_t WS_RSX = 384 * 1024;
constexpr size_t WS_SS1 = 128 * 1024, WS_SS2 = 256 * 1024;
constexpr size_t WS_PE = 886 * MiB;
constexpr size_t WS_HB8 = 1014 * MiB;
constexpr size_t WS_END = 1078 * MiB;
static_assert(WS_WIN + (size_t)DIN * DM * 2 <= WS_WOUT && WS_WOUT + (size_t)DM * DM * 2 <= WS_WGU && WS_WGU + (size_t)NGU * DM * 2 <= WS_WDN && WS_WDN + (size_t)DM * DFF * 2 <= WS_WPG && WS_WPG + (size_t)DM * DM * 2 <= WS_WPP && WS_WPP + (size_t)DM * PLE * 2 <= WS_WRA, "ws map: weights");
static_assert(WS_PB + (size_t)M * PLE * 2 <= WS_A1 && WS_A1 + (size_t)M * DM * 2 <= WS_A2 && WS_A2 + (size_t)M * DIN * 2 <= WS_PE && WS_HID + (size_t)M * DPITCH <= WS_HB && DPITCH % 128 == 0 && (DPITCH / 128 - DN8) % 2 == 0 && DN8 % 2 == 0 && WS_HB + (size_t)M * DM * 2 <= WS_PE && WS_PE + (size_t)M * DM * 2 <= WS_END, "ws map: activations");

constexpr int NWAVES = 8;
constexpr int LDS_BYTES = 147456;

#define GAS __attribute__((address_space(1)))
#define LAS __attribute__((address_space(3)))
typedef unsigned short bf16;
typedef unsigned v4u __attribute__((ext_vector_type(4)));
typedef unsigned v2u __attribute__((ext_vector_type(2)));
typedef float f32x4 __attribute__((ext_vector_type(4)));
typedef float f32x2 __attribute__((ext_vector_type(2)));
#define LDS_WAIT() asm volatile("s_waitcnt lgkmcnt(0)" ::: "memory")
__device__ __forceinline__ unsigned f2bf(float f) { unsigned u = __builtin_bit_cast(unsigned, f); return (u + 0x7fffu + ((u >> 16) & 1u)) >> 16; }
__device__ __forceinline__ unsigned pk2(float lo, float hi) { unsigned r; asm("v_cvt_pk_bf16_f32 %0, %1, %2" : "=v"(r) : "v"(lo), "v"(hi)); return r; }
__device__ __forceinline__ float bf_lo(unsigned w) { return __uint_as_float(w << 16); }
__device__ __forceinline__ float bf_hi(unsigned w) { return __uint_as_float(w & 0xffff0000u); }
using pg8::sxf; using pg8::sxu; using pg8::sum32; using pg8::max32;
__device__ __forceinline__ float wave_sum(float v) {
    v += sxf<1>(v); v += sxf<2>(v); v += sxf<4>(v); v += sxf<8>(v); v += sxf<16>(v);
    return sum32(v);
}

struct TrItem { const float* src; bf16* dst; const float* gain; int N, K, keep; float scale; };
__device__ __forceinline__ TrItem tr_make(const float* W, int K, int N, bf16* WT, int mode, const float* gain, int item) {
    const int nblk = N / 64, kb = item / nblk, nb = item % nblk, k0 = 64 * kb, n0 = 64 * nb;
    int drow0 = n0;
    if (mode == 1) drow0 = (n0 >> 7) * 256 + (n0 & 127);
    if (mode == 2) drow0 = (n0 >> 7) * 256 + 128 + (n0 & 127);
    TrItem t; t.src = W + (size_t)k0 * N + n0; t.dst = WT + (size_t)drow0 * K + k0; t.gain = gain ? gain + k0 : nullptr; t.N = N; t.K = K; t.keep = 0; t.scale = 1.0f; return t;
}
__device__ __forceinline__ void tr_load(const TrItem& t, f32x4 (&v)[16], int lane) {
    const int q = lane >> 4, c = lane & 15;
    const float* src = t.src + (size_t)(2 * q) * t.N + 4 * c;
#pragma unroll
    for (int i = 0; i < 16; ++i) v[i] = __builtin_nontemporal_load((const f32x4*)(src + (size_t)(8 * (i >> 1) + (i & 1)) * t.N));
}
__device__ __forceinline__ void tr_process(const TrItem& t, const f32x4 (&v)[16], LAS unsigned* scr, int lane) {
    const int q = lane >> 4, c = lane & 15;
    f32x2 gk[8];
#pragma unroll
    for (int j = 0; j < 8; ++j) gk[j] = (t.gain ? *(const f32x2*)(t.gain + 8 * j + 2 * q) : (f32x2){1.f, 1.f}) * t.scale;
#pragma unroll
    for (int j = 0; j < 8; ++j) { LAS unsigned* d = scr + (4 * j + q) * 65 + 4 * c;
        d[0] = pk2(v[2 * j].x * gk[j].x, v[2 * j + 1].x * gk[j].y); d[1] = pk2(v[2 * j].y * gk[j].x, v[2 * j + 1].y * gk[j].y);
        d[2] = pk2(v[2 * j].z * gk[j].x, v[2 * j + 1].z * gk[j].y); d[3] = pk2(v[2 * j].w * gk[j].x, v[2 * j + 1].w * gk[j].y); }
    LDS_WAIT(); asm volatile("" ::: "memory");
    const int a8 = lane & 7, b8 = lane >> 3;
#pragma unroll
    for (int m = 0; m < 8; ++m) { const int n = b8 + 8 * m; const LAS unsigned* s = scr + (4 * a8) * 65 + n;
        v4u o; o.x = s[0]; o.y = s[65]; o.z = s[130]; o.w = s[195];
        if (t.keep) *(v4u*)(t.dst + (size_t)n * t.K + 8 * a8) = o; else __builtin_nontemporal_store(o, (v4u*)(t.dst + (size_t)n * t.K + 8 * a8));
 }
    LDS_WAIT(); asm volatile("" ::: "memory");
}

__device__ __forceinline__ void tr8_load(const TrItem& t, f32x4 (&v)[16], int lane) {
    const int q = lane >> 4, c = lane & 15;
    const float* src = t.src + (size_t)(4 * q) * t.N + 4 * c;
#pragma unroll
    for (int i = 0; i < 16; ++i) v[i] = __builtin_nontemporal_load((const f32x4*)(src + (size_t)(16 * (i >> 2) + (i & 3)) * t.N));
}
__device__ __forceinline__ unsigned pk4_fp8(float a, float b, float c, float d) {
    int w = 0; w = __builtin_amdgcn_cvt_pk_fp8_f32(__builtin_amdgcn_fmed3f(a, -448.f, 448.f), __builtin_amdgcn_fmed3f(b, -448.f, 448.f), w, false);
    w = __builtin_amdgcn_cvt_pk_fp8_f32(__builtin_amdgcn_fmed3f(c, -448.f, 448.f), __builtin_amdgcn_fmed3f(d, -448.f, 448.f), w, true); return (unsigned)w;
}
__device__ __forceinline__ void tr8_process(const TrItem& t, const f32x4 (&v)[16], float scale, LAS unsigned* scr, int lane) {
    const int q = lane >> 4, c = lane & 15;
#pragma unroll
    for (int j = 0; j < 4; ++j) { f32x4 gk = t.gain ? *(const f32x4*)(t.gain + 16 * j + 4 * q) : (f32x4){1.f, 1.f, 1.f, 1.f}; gk = gk * scale;
        LAS unsigned* d = scr + (4 * j + q) * 65 + 4 * c;
        d[0] = pk4_fp8(v[4 * j].x * gk.x, v[4 * j + 1].x * gk.y, v[4 * j + 2].x * gk.z, v[4 * j + 3].x * gk.w);
        d[1] = pk4_fp8(v[4 * j].y * gk.x, v[4 * j + 1].y * gk.y, v[4 * j + 2].y * gk.z, v[4 * j + 3].y * gk.w);
        d[2] = pk4_fp8(v[4 * j].z * gk.x, v[4 * j + 1].z * gk.y, v[4 * j + 2].z * gk.z, v[4 * j + 3].z * gk.w);
        d[3] = pk4_fp8(v[4 * j].w * gk.x, v[4 * j + 1].w * gk.y, v[4 * j + 2].w * gk.z, v[4 * j + 3].w * gk.w); }
    LDS_WAIT(); asm volatile("" ::: "memory");
    const int a4 = lane & 3, b16 = lane >> 2;
#pragma unroll
    for (int m = 0; m < 4; ++m) { const int n = b16 + 16 * m; const LAS unsigned* s = scr + (4 * a4) * 65 + n;
        v4u o; o.x = s[0]; o.y = s[65]; o.z = s[130]; o.w = s[195];
        __builtin_nontemporal_store(o, (v4u*)((unsigned char*)t.dst + (size_t)n * t.K + 16 * a4)); }
    LDS_WAIT(); asm volatile("" ::: "memory");
}

__device__ __forceinline__ void row_load(const float* row, f32x4 (&v)[16], int lane) {
    const f32x4* xr = (const f32x4*)row + lane;
#pragma unroll
    for (int j = 0; j < 16; ++j) v[j] = __builtin_nontemporal_load(xr + 64 * j);
}
template <bool BF> __device__ __forceinline__ void row_finish(const f32x4 (&v)[16], const float* g, void* dstrow, int lane) {
    float s = 0.f;
#pragma unroll
    for (int j = 0; j < 16; ++j) s += (v[j].x * v[j].x + v[j].y * v[j].y) + (v[j].z * v[j].z + v[j].w * v[j].w);
    const float rstd = 1.0f / sqrtf(wave_sum(s) * (1.f / DM) + NORM_EPS);
    const f32x4* gr = (const f32x4*)g + lane;
    if (BF) { v2u* o8 = (v2u*)dstrow + lane;
#pragma unroll
        for (int j = 0; j < 16; ++j) { const f32x4 gg = gr[64 * j]; v2u w; w.x = pk2(v[j].x * rstd * gg.x, v[j].y * rstd * gg.y); w.y = pk2(v[j].z * rstd * gg.z, v[j].w * rstd * gg.w); o8[64 * j] = w; }
    } else { f32x4* o = (f32x4*)dstrow + lane;
#pragma unroll
        for (int j = 0; j < 16; ++j) { const f32x4 gg = gr[64 * j]; o[64 * j] = (f32x4){v[j].x * rstd * gg.x, v[j].y * rstd * gg.y, v[j].z * rstd * gg.z, v[j].w * rstd * gg.w}; } }
}
__device__ __forceinline__ unsigned q4_i8(float a, float b, float c, float d) {
    const int ia = (int)__builtin_rintf(a), ib = (int)__builtin_rintf(b), ic = (int)__builtin_rintf(c), id = (int)__builtin_rintf(d);
    return (unsigned)(ia & 255) | ((unsigned)(ib & 255) << 8) | ((unsigned)(ic & 255) << 16) | ((unsigned)id << 24);
}
__device__ __forceinline__ void row_cast_finish(const f32x4 (&v)[16], bf16* dstrow, signed char* q8row, float* rstd_out, int lane) {
    float s = 0.f, mx = 0.f;
#pragma unroll
    for (int j = 0; j < 16; ++j) { s += (v[j].x * v[j].x + v[j].y * v[j].y) + (v[j].z * v[j].z + v[j].w * v[j].w);
        mx = fmaxf(mx, fmaxf(fmaxf(fabsf(v[j].x), fabsf(v[j].y)), fmaxf(fabsf(v[j].z), fabsf(v[j].w)))); }
    const float rstd = 1.0f / sqrtf(wave_sum(s) * (1.f / DM) + NORM_EPS);
    mx = fmaxf(mx, sxf<1>(mx)); mx = fmaxf(mx, sxf<2>(mx)); mx = fmaxf(mx, sxf<4>(mx)); mx = fmaxf(mx, sxf<8>(mx)); mx = fmaxf(mx, sxf<16>(mx)); mx = max32(mx);
    const float inv = mx > 0.f ? 127.0f / mx : 0.f;
    if (lane == 0) { rstd_out[0] = rstd; rstd_out[(WS_RSXQ - WS_RSX) / 4] = rstd * (mx * (1.0f / 127.0f)); }
    { unsigned* o1 = (unsigned*)q8row + lane;
#pragma unroll
      for (int j = 0; j < 16; ++j) o1[64 * j] = q4_i8(v[j].x * inv, v[j].y * inv, v[j].z * inv, v[j].w * inv); }
    v2u* o8 = (v2u*)dstrow + lane;
#pragma unroll
    for (int j = 0; j < 16; ++j) { v2u w; w.x = pk2(v[j].x, v[j].y); w.y = pk2(v[j].z, v[j].w); o8[64 * j] = w; }
}
__device__ __forceinline__ void cast_rows(const float* src, bf16* dst, signed char* q8, float* rsx, int gw, int NGW, int lane) {
    int m = gw; if (m >= M) return;
    f32x4 va[16], vb[16];
    row_load(src + (size_t)m * DM, va, lane);
    for (;;) {
        { const int mn = m + NGW; const bool has = mn < M; row_load(src + (size_t)(has ? mn : m) * DM, vb, lane);
          row_cast_finish(va, dst + (size_t)m * DM, q8 + (size_t)m * DM, rsx + m, lane); if (!has) break; m = mn; }
        { const int mn = m + NGW; const bool has = mn < M; row_load(src + (size_t)(has ? mn : m) * DM, va, lane);
          row_cast_finish(vb, dst + (size_t)m * DM, q8 + (size_t)m * DM, rsx + m, lane); if (!has) break; m = mn; }
    }
}
template <bool BF> __device__ __forceinline__ void rms_rows(const float* src, const float* g, void* dst, int gw, int NGW, int lane) {
    int m = gw; if (m >= M) return;
    f32x4 va[16], vb[16];
    const size_t dpitch = BF ? (size_t)DM * 2 : (size_t)DM * 4;
    row_load(src + (size_t)m * DM, va, lane);
    for (;;) {
        { const int mn = m + NGW; const bool has = mn < M; row_load(src + (size_t)(has ? mn : m) * DM, vb, lane);
          row_finish<BF>(va, g, (char*)dst + (size_t)m * dpitch, lane); if (!has) break; m = mn; }
        { const int mn = m + NGW; const bool has = mn < M; row_load(src + (size_t)(has ? mn : m) * DM, va, lane);
          row_finish<BF>(vb, g, (char*)dst + (size_t)m * dpitch, lane); if (!has) break; m = mn; }
    }
}
__device__ __forceinline__ void rowb_load(const bf16* row, v4u (&v)[8], int lane) {
    const v4u* xr = (const v4u*)row + lane;
#pragma unroll
    for (int j = 0; j < 8; ++j) v[j] = __builtin_nontemporal_load(xr + 64 * j);
}
__device__ __forceinline__ void rowb_finish(const v4u (&w)[8], const float* g, float* dstrow, int lane) {
    float s = 0.f;
#pragma unroll
    for (int j = 0; j < 8; ++j)
#pragma unroll
        for (int e = 0; e < 4; ++e) { const float a = bf_lo(w[j][e]), b = bf_hi(w[j][e]); s += a * a + b * b; }
    const float rstd = 1.0f / sqrtf(wave_sum(s) * (1.f / DM) + NORM_EPS);
#pragma unroll
    for (int j = 0; j < 8; ++j) { const f32x4* gp = (const f32x4*)(g + (64 * j + lane) * 8); const f32x4 g0 = gp[0], g1 = gp[1]; f32x4* o = (f32x4*)(dstrow + (64 * j + lane) * 8);
        __builtin_nontemporal_store((f32x4){bf_lo(w[j].x) * rstd * g0.x, bf_hi(w[j].x) * rstd * g0.y, bf_lo(w[j].y) * rstd * g0.z, bf_hi(w[j].y) * rstd * g0.w}, o);
        __builtin_nontemporal_store((f32x4){bf_lo(w[j].z) * rstd * g1.x, bf_hi(w[j].z) * rstd * g1.y, bf_lo(w[j].w) * rstd * g1.z, bf_hi(w[j].w) * rstd * g1.w}, o + 1); }
}
__device__ __forceinline__ void rms_rows_b2f(const bf16* src, const float* g, float* dst, int gw, int NGW, int lane) {
    int m = gw; if (m >= M) return;
    v4u va[8], vb[8];
    rowb_load(src + (size_t)m * DM, va, lane);
    for (;;) {
        { const int mn = m + NGW; const bool has = mn < M; rowb_load(src + (size_t)(has ? mn : m) * DM, vb, lane);
          rowb_finish(va, g, dst + (size_t)m * DM, lane); if (!has) break; m = mn; }
        { const int mn = m + NGW; const bool has = mn < M; rowb_load(src + (size_t)(has ? mn : m) * DM, va, lane);
          rowb_finish(vb, g, dst + (size_t)m * DM, lane); if (!has) break; m = mn; }
    }
}
template <bool RSTD = false>
__device__ __forceinline__ void quant_rows_i8(const bf16* src, signed char* dst, float* scale, int nrows, int gw, int NGW, int lane) {
    for (int r = gw; r < nrows; r += NGW) {
        const v4u* p = (const v4u*)(src + (size_t)r * 4096) + lane; v4u w[8];
#pragma unroll
        for (int j = 0; j < 8; ++j) w[j] = __builtin_nontemporal_load(p + 64 * j);
        unsigned mb = 0u;
#pragma unroll
        for (int j = 0; j < 8; ++j)
#pragma unroll
            for (int e = 0; e < 4; ++e) { const unsigned lo_ = (w[j][e] << 16) & 0x7fff0000u, hi_ = w[j][e] & 0x7fff0000u; mb = mb > lo_ ? mb : lo_; mb = mb > hi_ ? mb : hi_; }
        float mx = __uint_as_float(mb);
        mx = fmaxf(mx, sxf<1>(mx)); mx = fmaxf(mx, sxf<2>(mx)); mx = fmaxf(mx, sxf<4>(mx)); mx = fmaxf(mx, sxf<8>(mx)); mx = fmaxf(mx, sxf<16>(mx)); mx = max32(mx);
        const float inv = mx > 0.f ? 127.0f / mx : 0.f;
        float rstd = 1.0f;
        if constexpr (RSTD) { float sq = 0.f;
#pragma unroll
            for (int j = 0; j < 8; ++j)
#pragma unroll
                for (int e = 0; e < 4; ++e) { const float a = bf_lo(w[j][e]), b = bf_hi(w[j][e]); sq += a * a + b * b; }
            rstd = __builtin_amdgcn_rsqf(wave_sum(sq) * (1.0f / 4096.0f) + NORM_EPS); }
        if (lane == 0) scale[r] = rstd * (mx * (1.0f / 127.0f));
        v2u* o = (v2u*)(dst + (size_t)r * 4096) + lane;
#pragma unroll
        for (int j = 0; j < 8; ++j) { v2u q; q.x = q4_i8(bf_lo(w[j].x) * inv, bf_hi(w[j].x) * inv, bf_lo(w[j].y) * inv, bf_hi(w[j].y) * inv); q.y = q4_i8(bf_lo(w[j].z) * inv, bf_hi(w[j].z) * inv, bf_lo(w[j].w) * inv, bf_hi(w[j].w) * inv); o[64 * j] = q; }
    }
}
__device__ __forceinline__ void rms_seg2048_bf16(bf16* seg, const float* g, int lane) {
    v4u* p = (v4u*)seg + lane; v4u w[4]; float s = 0.f;
#pragma unroll
    for (int j = 0; j < 4; ++j) { w[j] = p[64 * j];
#pragma unroll
        for (int e = 0; e < 4; ++e) { const float a = bf_lo(w[j][e]), b = bf_hi(w[j][e]); s += a * a + b * b; } }
    const float rstd = 1.0f / sqrtf(wave_sum(s) * (1.f / 2048.f) + NORM_EPS);
#pragma unroll
    for (int j = 0; j < 4; ++j) { const f32x4* gp = (const f32x4*)(g + (64 * j + lane) * 8); const f32x4 g0 = gp[0], g1 = gp[1]; v4u o;
        o.x = pk2(bf_lo(w[j].x) * rstd * g0.x, bf_hi(w[j].x) * rstd * g0.y); o.y = pk2(bf_lo(w[j].y) * rstd * g0.z, bf_hi(w[j].y) * rstd * g0.w);
        o.z = pk2(bf_lo(w[j].z) * rstd * g1.x, bf_hi(w[j].z) * rstd * g1.y); o.w = pk2(bf_lo(w[j].w) * rstd * g1.z, bf_hi(w[j].w) * rstd * g1.w);
        p[64 * j] = o; }
}
__device__ __forceinline__ void rms_row4096_bf16(bf16* row, const float* g, int lane) {
    v4u* p = (v4u*)row + lane; v4u w[8]; float s = 0.f;
#pragma unroll
    for (int j = 0; j < 8; ++j) { w[j] = p[64 * j];
#pragma unroll
        for (int e = 0; e < 4; ++e) { const float a = bf_lo(w[j][e]), b = bf_hi(w[j][e]); s += a * a + b * b; } }
    const float rstd = 1.0f / sqrtf(wave_sum(s) * (1.f / 4096.f) + NORM_EPS);
#pragma unroll
    for (int j = 0; j < 8; ++j) { const f32x4* gp = (const f32x4*)(g + (64 * j + lane) * 8); const f32x4 g0 = gp[0], g1 = gp[1]; v4u o;
        o.x = pk2(bf_lo(w[j].x) * rstd * g0.x, bf_hi(w[j].x) * rstd * g0.y); o.y = pk2(bf_lo(w[j].y) * rstd * g0.z, bf_hi(w[j].y) * rstd * g0.w);
        o.z = pk2(bf_lo(w[j].z) * rstd * g1.x, bf_hi(w[j].z) * rstd * g1.y); o.w = pk2(bf_lo(w[j].w) * rstd * g1.z, bf_hi(w[j].w) * rstd * g1.w);
        p[64 * j] = o; }
}

struct Args {
    const float *x, *p, *g_mix, *w_in, *conv_w, *conv_b, *w_rg_a, *b_rg_a, *w_rg_x, *b_rg_x, *rg_lambda, *g_attn_out, *g_rnn_out, *w_out, *g_ffn, *w_ffn_gate, *w_ffn_up, *w_ffn_down, *g_ple, *w_ple_gate, *w_ple_proj, *g_ple_out, *g_final;
    float* out; unsigned char* ws;
};

#define XB_TMO      128
#define XB_XCNT(j)  (256  + 64 * (j))
#define XB_XSUB(j)  (1280 + 64 * (j))
#define XB_XGEN(j)  (2304 + 64 * (j))
#define XB_TOP      3328
#define XB_TOPGEN   3392
#define XCD_BAR_WORDS 3456
#define XB_SPIN_CAP (1u << 18)

__device__ __forceinline__ unsigned xb_ld(unsigned* p)              { return __hip_atomic_load(p, __ATOMIC_RELAXED, __HIP_MEMORY_SCOPE_AGENT); }
__device__ __forceinline__ unsigned xb_add(unsigned* p, unsigned v) { return __hip_atomic_fetch_add(p, v, __ATOMIC_RELAXED, __HIP_MEMORY_SCOPE_AGENT); }
__device__ __forceinline__ unsigned xb_xcc_id() { return (unsigned)__builtin_amdgcn_s_getreg((3 << 11) | 20) & 0xFu; }
#define XB_SPIN(cond, bar) do { unsigned _sp = 0; while (cond) { __builtin_amdgcn_s_sleep(1); \
    if ((++_sp & 255u) == 0u) { if (xb_ld(&(bar)[XB_TMO])) break; if (_sp > XB_SPIN_CAP) { atomicAdd(&(bar)[XB_TMO], 1u); break; } } } } while (0)

struct XcdBarrier {
    unsigned* bar; unsigned x;
    volatile LAS unsigned* st;
};
__device__ __forceinline__ XcdBarrier xcd_barrier_post(unsigned* bar, volatile LAS unsigned* st) {
    XcdBarrier b; b.bar = bar; b.x = xb_xcc_id(); b.st = st;
    if (threadIdx.x == 0) (void)xb_add(&bar[XB_XCNT(b.x)], 1u);
    return b;
}
__device__ __forceinline__ void xcd_barrier_complete(unsigned* bar, unsigned x, unsigned& nloc, unsigned& nx) {
    const unsigned G = gridDim.x * gridDim.y * gridDim.z;
    unsigned sum, cnt, mine, sp = 0u;
    for (;;) {
        sum = 0u; cnt = 0u; mine = 0u;
#pragma unroll
        for (unsigned j = 0; j < 16; ++j) { const unsigned c = xb_ld(&bar[XB_XCNT(j)]); sum += c; cnt += (c > 0u) ? 1u : 0u; mine = (j == x) ? c : mine; }
        if (sum == G) break;
        __builtin_amdgcn_s_sleep(1);
        if ((++sp & 255u) == 0u) { if (xb_ld(&bar[XB_TMO])) break; if (sp > XB_SPIN_CAP) { atomicAdd(&bar[XB_TMO], 1u); break; } }
    }
    nloc = mine > 0u ? mine : 1u; nx = cnt > 0u ? cnt : 1u;
}
__device__ __forceinline__ void xcd_barrier(const XcdBarrier& b) {
    asm volatile("s_waitcnt vmcnt(0)" ::: "memory");
    __syncthreads();
    if (threadIdx.x == 0) {
        unsigned* bar = b.bar;
        __builtin_amdgcn_s_waitcnt(0);
        unsigned nloc = b.st[0], nx = b.st[1];
        if (nloc == 0u) { xcd_barrier_complete(bar, b.x, nloc, nx); b.st[0] = nloc; b.st[1] = nx; }
        const unsigned old = xb_add(&bar[XB_XSUB(b.x)], 1u);
        const unsigned gen = old / nloc;
        if (old + 1u == (gen + 1u) * nloc) {
            __builtin_amdgcn_fence(__ATOMIC_RELEASE, "agent");
            asm volatile("s_waitcnt vmcnt(0)" ::: "memory");
            const unsigned og = xb_add(&bar[XB_TOP], 1u);
            const unsigned tg = og / nx;
            if (og + 1u == (tg + 1u) * nx) xb_add(&bar[XB_TOPGEN], 1u);
            else XB_SPIN(xb_ld(&bar[XB_TOPGEN]) == tg, bar);
            __builtin_amdgcn_fence(__ATOMIC_ACQUIRE, "agent");
            xb_add(&bar[XB_XGEN(b.x)], 1u);
            asm volatile("s_waitcnt vmcnt(0)" ::: "memory");
        } else {
            XB_SPIN(xb_ld(&bar[XB_XGEN(b.x)]) == gen, bar);
            __builtin_amdgcn_fence(__ATOMIC_ACQUIRE, "agent");
            asm volatile("s_waitcnt vmcnt(0)" ::: "memory");
        }
    }
    __syncthreads();
}

namespace rg {
constexpr int RT = 128, NT = SEQ / RT;
constexpr int XCT_BYTES = RT * 256, GRT_BYTES = RT * 64;
constexpr int XCT_OFF = 0, GRT_OFF = 2 * XCT_BYTES, OUT_OFF = GRT_OFF + 2 * GRT_BYTES, SUM_OFF = OUT_OFF + RT * 64, LDS_END = SUM_OFF + 2 * 1024;
typedef short bf16x8 __attribute__((ext_vector_type(8)));
__device__ __forceinline__ float sigmoidf_fast(float x) { return __builtin_amdgcn_rcpf(1.0f + __builtin_amdgcn_exp2f(-1.4426950408889634f * x)); }

__device__ __forceinline__ void rglru_unit(const Args& a, const bf16* proj, bf16* mixed, float* part, const bf16* wra_t, const bf16* wrx_t, LAS unsigned char* lds, int unit) {
    int tid_ = threadIdx.x; asm volatile("" : "+v"(tid_));
    const int tid = tid_, lane = tid & 63, wave = __builtin_amdgcn_readfirstlane(tid >> 6), fr = lane & 15, fq = lane >> 4;
    const int cg = wave & 1, ts = wave >> 1;
    const int b = unit >> 6, n = (unit >> 2) & 15, cq = unit & 3;
    const int ch0 = n * 128, oc = cq * 32 + cg * 16 + fr, c = ch0 + oc;
    bf16x8 Ba[4], Bx[4];
#pragma unroll
    for (int ks = 0; ks < 4; ++ks) { Ba[ks] = *(const bf16x8*)(wra_t + (size_t)n * 16384 + oc * 128 + 32 * ks + 8 * fq); Bx[ks] = *(const bf16x8*)(wrx_t + (size_t)n * 16384 + oc * 128 + 32 * ks + 8 * fq); }
    const float b_a = a.b_rg_a[c], b_x = a.b_rg_x[c];
    const float cl = 8.0f * 1.4426950408889634f * log1pf(expf(-a.rg_lambda[c]));
    const int s_chunk = tid & 15, s_tg = tid >> 4;
    float cw[4][8], cb[8];
#pragma unroll
    for (int k = 0; k < 4; ++k) { const f32x4 w0 = *(const f32x4*)(a.conv_w + k * DR + ch0 + 8 * s_chunk), w1 = *(const f32x4*)(a.conv_w + k * DR + ch0 + 8 * s_chunk + 4);
        cw[k][0] = w0.x; cw[k][1] = w0.y; cw[k][2] = w0.z; cw[k][3] = w0.w; cw[k][4] = w1.x; cw[k][5] = w1.y; cw[k][6] = w1.z; cw[k][7] = w1.w; }
    { const f32x4 w0 = *(const f32x4*)(a.conv_b + ch0 + 8 * s_chunk), w1 = *(const f32x4*)(a.conv_b + ch0 + 8 * s_chunk + 4);
      cb[0] = w0.x; cb[1] = w0.y; cb[2] = w0.z; cb[3] = w0.w; cb[4] = w1.x; cb[5] = w1.y; cb[6] = w1.z; cb[7] = w1.w; }
    const bf16* xr_base = proj + (size_t)b * SEQ * DIN + COL_XR + ch0 + 8 * s_chunk;
    const bf16* gr_base = proj + (size_t)b * SEQ * DIN + COL_GR + ch0 + cq * 32 + 8 * (tid & 3);
    bf16* out_base = mixed + (size_t)b * SEQ * DM + DA + ch0 + cq * 32 + 8 * (tid & 3);
    v4u xr7[7], grv;
#define RG_LOAD(i) do { const int t0_ = (i) * RT + 4 * s_tg - 3; _Pragma("unroll") for (int k = 0; k < 7; ++k) { const int tt = t0_ + k; \
        xr7[k] = (tt >= 0) ? *(const v4u*)(xr_base + (size_t)tt * DIN) : (v4u){0u, 0u, 0u, 0u}; } \
        grv = *(const v4u*)(gr_base + (size_t)((i) * RT + (tid >> 2)) * DIN); } while (0)
#define RG_CONV_WRITE(buf) do { _Pragma("unroll") for (int j = 0; j < 4; ++j) { float o[8]; _Pragma("unroll") for (int e = 0; e < 8; ++e) o[e] = cb[e]; \
        _Pragma("unroll") for (int k = 0; k < 4; ++k) { const v4u xv = xr7[j + k]; \
            o[0] += cw[k][0] * bf_lo(xv.x); o[1] += cw[k][1] * bf_hi(xv.x); o[2] += cw[k][2] * bf_lo(xv.y); o[3] += cw[k][3] * bf_hi(xv.y); \
            o[4] += cw[k][4] * bf_lo(xv.z); o[5] += cw[k][5] * bf_hi(xv.z); o[6] += cw[k][6] * bf_lo(xv.w); o[7] += cw[k][7] * bf_hi(xv.w); } \
        const int tok = 4 * s_tg + j; v4u w; w.x = pk2(o[0], o[1]); w.y = pk2(o[2], o[3]); w.z = pk2(o[4], o[5]); w.w = pk2(o[6], o[7]); \
        *(LAS v4u*)(lds + XCT_OFF + (buf) * XCT_BYTES + tok * 256 + ((s_chunk * 16) ^ ((tok & 7) << 4))) = w; } \
        *(LAS v4u*)(lds + GRT_OFF + (buf) * GRT_BYTES + (tid >> 2) * 64 + (tid & 3) * 16) = grv; } while (0)
    RG_LOAD(0);
    RG_CONV_WRITE(0);
    __syncthreads();
    float carry = 0.f;
    for (int i = 0; i < NT; ++i) {
        const int cur = i & 1;
        if (i + 1 < NT) RG_LOAD(i + 1);
        const LAS unsigned char* xct = lds + XCT_OFF + cur * XCT_BYTES; const LAS unsigned char* grt = lds + GRT_OFF + cur * GRT_BYTES;
        float hl[2][4], pl[2][4], gate[2][4], Pex[2], Hex[2], P16[2], H16[2];
#pragma unroll
        for (int g = 0; g < 2; ++g) {
            const int tokb = 32 * ts + 16 * g;
            f32x4 accA = {0.f, 0.f, 0.f, 0.f}, accX = {0.f, 0.f, 0.f, 0.f};
            { const int tok = tokb + fr;
#pragma unroll
              for (int ks = 0; ks < 4; ++ks) { const bf16x8 A = *(const LAS bf16x8*)(xct + tok * 256 + (((4 * ks + fq) * 16) ^ ((tok & 7) << 4)));
                  accA = __builtin_amdgcn_mfma_f32_16x16x32_bf16(A, Ba[ks], accA, 0, 0, 0); accX = __builtin_amdgcn_mfma_f32_16x16x32_bf16(A, Bx[ks], accX, 0, 0, 0); } }
            float av[4], uv[4];
#pragma unroll
            for (int e = 0; e < 4; ++e) { const int tok = tokb + 4 * fq + e;
                const float xcv = __uint_as_float((unsigned)*(const LAS unsigned short*)(xct + tok * 256 + (((oc >> 3) * 16) ^ ((tok & 7) << 4)) + (oc & 7) * 2) << 16);
                const float gv = __uint_as_float((unsigned)*(const LAS unsigned short*)(grt + tok * 64 + (cg * 16 + fr) * 2) << 16);
                const float r = sigmoidf_fast(accA[e] + b_a), ig = sigmoidf_fast(accX[e] + b_x);
                const float aa = __builtin_amdgcn_exp2f(-cl * r);
                av[e] = aa; uv[e] = __builtin_amdgcn_sqrtf(fmaxf(1.0f - aa * aa, 0.f)) * ig * xcv;
                const float inner = 0.7978845608028654f * (gv + 0.044715f * gv * gv * gv);
                gate[g][e] = gv * sigmoidf_fast(2.0f * inner); }
            hl[g][0] = uv[0]; pl[g][0] = av[0];
#pragma unroll
            for (int e = 1; e < 4; ++e) { hl[g][e] = av[e] * hl[g][e - 1] + uv[e]; pl[g][e] = pl[g][e - 1] * av[e]; }
            float P = pl[g][3], H = hl[g][3];
            { const float Pl = __shfl_up(P, 16), Hl = __shfl_up(H, 16); if (fq >= 1) { H = P * Hl + H; P = Pl * P; } }
            { const float Pl = __shfl_up(P, 32), Hl = __shfl_up(H, 32); if (fq >= 2) { H = P * Hl + H; P = Pl * P; } }
            { const float Pe = __shfl_up(P, 16), He = __shfl_up(H, 16); Pex[g] = fq >= 1 ? Pe : 1.0f; Hex[g] = fq >= 1 ? He : 0.0f; }
            P16[g] = __shfl(P, 48 + fr); H16[g] = __shfl(H, 48 + fr);
        }
        { const float P32 = P16[0] * P16[1], H32 = P16[1] * H16[0] + H16[1];
          if (fq == 0) *(LAS f32x2*)(lds + SUM_OFF + cur * 1024 + ((cg * 4 + ts) * 16 + fr) * 8) = (f32x2){P32, H32}; }
        __syncthreads();
        float cin;
        { const f32x2 s0 = *(const LAS f32x2*)(lds + SUM_OFF + cur * 1024 + ((cg * 4 + 0) * 16 + fr) * 8), s1 = *(const LAS f32x2*)(lds + SUM_OFF + cur * 1024 + ((cg * 4 + 1) * 16 + fr) * 8),
                 s2 = *(const LAS f32x2*)(lds + SUM_OFF + cur * 1024 + ((cg * 4 + 2) * 16 + fr) * 8), s3 = *(const LAS f32x2*)(lds + SUM_OFF + cur * 1024 + ((cg * 4 + 3) * 16 + fr) * 8);
          const float c0 = carry, c1 = s0.x * c0 + s0.y, c2 = s1.x * c1 + s1.y, c3 = s2.x * c2 + s2.y, c4 = s3.x * c3 + s3.y;
          cin = ts == 0 ? c0 : (ts == 1 ? c1 : (ts == 2 ? c2 : c3)); carry = c4; }
#pragma unroll
        for (int g = 0; g < 2; ++g) {
            const float cgin = g == 0 ? cin : (P16[0] * cin + H16[0]);
            const float clane = Pex[g] * cgin + Hex[g];
#pragma unroll
            for (int e = 0; e < 4; ++e) { const int tok = 32 * ts + 16 * g + 4 * fq + e; const float h = hl[g][e] + pl[g][e] * clane;
                *(LAS unsigned short*)(lds + OUT_OFF + tok * 64 + (cg * 16 + fr) * 2) = (unsigned short)f2bf(h * gate[g][e]); }
        }
        if (i + 1 < NT) RG_CONV_WRITE(cur ^ 1);
        __syncthreads();
        { const v4u o = *(const LAS v4u*)(lds + OUT_OFF + (tid >> 2) * 64 + (tid & 3) * 16); *(v4u*)(out_base + (size_t)(i * RT + (tid >> 2)) * DM) = o;
          float sq = 0.f;
#pragma unroll
          for (int e = 0; e < 4; ++e) { const float lo_ = __uint_as_float(o[e] << 16), hi_ = __uint_as_float(o[e] & 0xffff0000u); sq += lo_ * lo_ + hi_ * hi_; }
          sq += sxf<1>(sq); sq += sxf<2>(sq);
          if ((tid & 3) == 0) part[(size_t)(b * SEQ + i * RT + (tid >> 2)) * 128 + 64 + n * 4 + cq] = sq; }
    }
    __syncthreads();
#undef RG_LOAD
#undef RG_CONV_WRITE
}
}

namespace att {
typedef short bf16x8 __attribute__((ext_vector_type(8)));
typedef short s16x4 __attribute__((ext_vector_type(4)));
typedef float f32x16 __attribute__((ext_vector_type(16)));
constexpr int KVBLK = 64, SHM_V = KVBLK * 128 * 2, SHM_K = SHM_V, FLAG_OFF = 2 * SHM_V + 2 * SHM_K;
#define ATT_KSWZ(row, colB) ((row) * 256 + ((colB) ^ (((row) & 7) << 4)))
#define ATT_SBAR() __builtin_amdgcn_sched_barrier(0)
__device__ __forceinline__ int crow(int r, int hi) { return (r & 3) + 8 * (r >> 2) + 4 * hi; }
__device__ __forceinline__ unsigned cvtpk(float lo, float hi) { unsigned r; asm volatile("v_cvt_pk_bf16_f32 %0, %1, %2" : "=v"(r) : "v"(lo), "v"(hi)); return r; }
__device__ __forceinline__ int v_st(int k, int c) { const int kk = (k & ~0xC) | ((k & 4) << 1) | ((k & 8) >> 1); return ((kk >> 3) * 4 + (c >> 5)) * 512 + ((kk & 7) * 32 + (c & 31)) * 2; }
__device__ __forceinline__ int v_rd_base(int lane) { return ((lane & 3) << 3) | (((lane >> 2) & 3) << 6) | (((lane >> 4) & 1) << 5) | (((lane >> 5) & 1) << 8); }
constexpr int v_rd_off(int d0, int ks, int half) { return d0 * 512 + ks * 4096 + half * 2048; }
template <int OFF> __device__ __forceinline__ s16x4 tr_read(int vb) { s16x4 r; asm volatile("ds_read_b64_tr_b16 %0, %1 offset:%2" : "=&v"(r) : "v"(vb), "i"(OFF) : "memory"); return r; }
template <int D0> __device__ __forceinline__ void pv_one(f32x16& od, int vb, bf16x8 pa0, bf16x8 pa1, bf16x8 pa2, bf16x8 pa3) {
    const s16x4 l0 = tr_read<v_rd_off(D0, 0, 0)>(vb), h0 = tr_read<v_rd_off(D0, 0, 1)>(vb), l1 = tr_read<v_rd_off(D0, 1, 0)>(vb), h1 = tr_read<v_rd_off(D0, 1, 1)>(vb);
    const s16x4 l2 = tr_read<v_rd_off(D0, 2, 0)>(vb), h2 = tr_read<v_rd_off(D0, 2, 1)>(vb), l3 = tr_read<v_rd_off(D0, 3, 0)>(vb), h3 = tr_read<v_rd_off(D0, 3, 1)>(vb);
    asm volatile("s_waitcnt lgkmcnt(0)" ::: "memory"); ATT_SBAR();
#define ATT_PK(L, H) (bf16x8){L[0], L[1], L[2], L[3], H[0], H[1], H[2], H[3]}
    od = __builtin_amdgcn_mfma_f32_32x32x16_bf16(pa0, ATT_PK(l0, h0), od, 0, 0, 0);
    od = __builtin_amdgcn_mfma_f32_32x32x16_bf16(pa1, ATT_PK(l1, h1), od, 0, 0, 0);
    od = __builtin_amdgcn_mfma_f32_32x32x16_bf16(pa2, ATT_PK(l2, h2), od, 0, 0, 0);
    od = __builtin_amdgcn_mfma_f32_32x32x16_bf16(pa3, ATT_PK(l3, h3), od, 0, 0, 0);
#undef ATT_PK
}
__device__ __forceinline__ void sb_block(f32x16& P, float& Crow, int KB, int trow, int hi, bool diag) {
    float sp[16];
#pragma unroll
    for (int r = 0; r < 16; ++r) { const float y = P[r]; sp[r] = fmaxf(y, 0.f) + __builtin_amdgcn_logf(1.0f + __builtin_amdgcn_exp2f(-fabsf(y))); }
    if (diag) {
#pragma unroll
        for (int r = 0; r < 16; ++r) if (KB + crow(r, hi) >= trow) sp[r] = 0.f;
    }
    float lo[4], hh[4];
#pragma unroll
    for (int k = 0; k < 4; ++k) { const float g = (sp[4 * k] + sp[4 * k + 1]) + (sp[4 * k + 2] + sp[4 * k + 3]);
        auto rr = __builtin_amdgcn_permlane32_swap(__float_as_uint(g), __float_as_uint(g), false, false);
        lo[k] = __uint_as_float(rr[0]); hh[k] = __uint_as_float(rr[1]); }
    float tot = Crow;
#pragma unroll
    for (int k = 3; k >= 0; --k) {
        const float after = tot + (hi == 0 ? hh[k] : 0.f);
        const float c3 = after + sp[4 * k + 3], c2 = c3 + sp[4 * k + 2], c1 = c2 + sp[4 * k + 1], c0 = c1 + sp[4 * k];
        P[4 * k + 3] = __builtin_amdgcn_exp2f(P[4 * k + 3] - c3); P[4 * k + 2] = __builtin_amdgcn_exp2f(P[4 * k + 2] - c2);
        P[4 * k + 1] = __builtin_amdgcn_exp2f(P[4 * k + 1] - c1); P[4 * k] = __builtin_amdgcn_exp2f(P[4 * k] - c0);
        tot += lo[k] + hh[k];
    }
    Crow = tot;
    if (diag) {
#pragma unroll
        for (int r = 0; r < 16; ++r) if (KB + crow(r, hi) >= trow) P[r] = 0.f;
    }
}

__device__ __forceinline__ void attn_unit(const bf16* proj, bf16* mixed, float* part, LAS unsigned char* lds, int unit) {
    int tid_ = threadIdx.x; asm volatile("" : "+v"(tid_));
    const int tid = tid_, wid = __builtin_amdgcn_readfirstlane(tid >> 6), lane = tid & 63, r32 = lane & 31, hi = lane >> 5;
    const int qb = unit & 15, h = (unit >> 4) & 15, b = unit >> 8, q0 = qb * 256;
    LAS unsigned char* V_lds = lds; LAS unsigned char* K_lds = lds + 2 * SHM_V; volatile LAS int* flags = (volatile LAS int*)(lds + FLAG_OFF);
    const bf16* Kh = proj + (size_t)b * SEQ * DIN + COL_K + h * HD; const bf16* Vh = proj + (size_t)b * SEQ * DIN + COL_V + h * HD;
    f32x16 o[4];
#pragma unroll
    for (int d = 0; d < 4; ++d)
#pragma unroll
        for (int r = 0; r < 16; ++r) o[d][r] = 0.f;
    bf16x8 qr[8];
    { const bf16* Qw = proj + (size_t)(b * SEQ + q0 + wid * 32 + r32) * DIN + COL_Q + h * HD + hi * 8;
#pragma unroll
      for (int d0 = 0; d0 < 8; ++d0) qr[d0] = *(const bf16x8*)(Qw + d0 * 16); }
    const int trow = q0 + wid * 32 + r32, jw = 4 * qb + (wid >> 1), jmax = 4 * qb + 3;
    const int sr = tid >> 4, sc = (tid & 15) * 8, vst0 = v_st(sr, sc), vst1 = v_st(32 + sr, sc);
    const int vb0 = (int)(unsigned)(size_t)V_lds + v_rd_base(lane);
    bf16x8 vs0, vs1, ks0, ks1;
#define ATT_SLOAD(k0) do { vs0 = *(const bf16x8*)(Vh + (size_t)((k0) + sr) * DIN + sc); vs1 = *(const bf16x8*)(Vh + (size_t)((k0) + 32 + sr) * DIN + sc); \
        ks0 = *(const bf16x8*)(Kh + (size_t)((k0) + sr) * DIN + sc); ks1 = *(const bf16x8*)(Kh + (size_t)((k0) + 32 + sr) * DIN + sc); } while (0)
#define ATT_SWRITE(bb) do { *(LAS bf16x8*)(V_lds + (bb) * SHM_V + vst0) = vs0; *(LAS bf16x8*)(V_lds + (bb) * SHM_V + vst1) = vs1; \
        *(LAS bf16x8*)(K_lds + (bb) * SHM_K + ATT_KSWZ(sr, sc * 2)) = ks0; *(LAS bf16x8*)(K_lds + (bb) * SHM_K + ATT_KSWZ(32 + sr, sc * 2)) = ks1; } while (0)
    ATT_SLOAD(jmax * KVBLK); ATT_SWRITE(0);
    __syncthreads();
    float Crow = 0.f; bool wdone = false;
    for (int j = jmax, it = 0; j >= 0; --j, ++it) {
        const int cb = it & 1;
        if (j > 0) ATT_SLOAD((j - 1) * KVBLK);
        if (j <= jw && !wdone) {
            f32x16 p0, p1;
#pragma unroll
            for (int r = 0; r < 16; ++r) { p0[r] = 0.f; p1[r] = 0.f; }
            const LAS unsigned char* Ks = K_lds + cb * SHM_K;
#pragma unroll
            for (int d0 = 0; d0 < 8; ++d0) { const int cbyte = (d0 * 16 + hi * 8) * 2;
                const bf16x8 b0 = *(const LAS bf16x8*)(Ks + ATT_KSWZ(r32, cbyte)), b1 = *(const LAS bf16x8*)(Ks + ATT_KSWZ(32 + r32, cbyte));
                p0 = __builtin_amdgcn_mfma_f32_32x32x16_bf16(b0, qr[d0], p0, 0, 0, 0); p1 = __builtin_amdgcn_mfma_f32_32x32x16_bf16(b1, qr[d0], p1, 0, 0, 0); }
            const bool diag = (64 * j + 63 >= q0 + wid * 32);
            sb_block(p1, Crow, 64 * j + 32, trow, hi, diag);
            sb_block(p0, Crow, 64 * j, trow, hi, diag);
            bf16x8 pa0, pa1, pa2, pa3;
#define ATT_PK4(P, BASE, OUT) do { unsigned a0 = cvtpk(P[BASE + 0], P[BASE + 1]), a1 = cvtpk(P[BASE + 2], P[BASE + 3]); \
        unsigned b0_ = cvtpk(P[BASE + 4], P[BASE + 5]), b1_ = cvtpk(P[BASE + 6], P[BASE + 7]); \
        auto r0 = __builtin_amdgcn_permlane32_swap(a0, b0_, false, false); auto r1 = __builtin_amdgcn_permlane32_swap(a1, b1_, false, false); \
        v4u w_ = {r0[0], r1[0], r0[1], r1[1]}; OUT = *reinterpret_cast<bf16x8*>(&w_); } while (0)
            ATT_PK4(p0, 0, pa0); ATT_PK4(p0, 8, pa1); ATT_PK4(p1, 0, pa2); ATT_PK4(p1, 8, pa3);
#undef ATT_PK4
            const int vb = vb0 + cb * SHM_V;
            pv_one<0>(o[0], vb, pa0, pa1, pa2, pa3); pv_one<1>(o[1], vb, pa0, pa1, pa2, pa3); pv_one<2>(o[2], vb, pa0, pa1, pa2, pa3); pv_one<3>(o[3], vb, pa0, pa1, pa2, pa3);
            wdone = __all(Crow > C2_EXIT);
        }
        if (lane == 0) flags[(it & 1) * 8 + wid] = (j <= jw && wdone) ? 1 : 0;
        if (j > 0) ATT_SWRITE(cb ^ 1);
        __syncthreads();
        if (j > 0) { const int f = flags[(it & 1) * 8 + (lane & 7)]; if (__all(f != 0)) break; }
    }
    { LAS unsigned char* stg = lds + wid * 8192;
#pragma unroll
      for (int d0 = 0; d0 < 4; ++d0)
#pragma unroll
          for (int r = 0; r < 16; ++r) *(LAS unsigned short*)(stg + crow(r, hi) * 256 + (d0 * 32 + r32) * 2) = (unsigned short)f2bf(o[d0][r]);
      asm volatile("s_waitcnt lgkmcnt(0)" ::: "memory");
      bf16* Ob = mixed + (size_t)(b * SEQ + q0 + wid * 32) * DM + h * HD;
#pragma unroll
      for (int k = 0; k < 8; ++k) { const int id = lane + 64 * k, row = id >> 4, ch = id & 15; const v4u v = *(const LAS v4u*)(stg + row * 256 + ch * 16); *(v4u*)(Ob + (size_t)row * DM + ch * 8) = v;
          float sq = 0.f;
#pragma unroll
          for (int e = 0; e < 4; ++e) { const float lo_ = __uint_as_float(v[e] << 16), hi_ = __uint_as_float(v[e] & 0xffff0000u); sq += lo_ * lo_ + hi_ * hi_; }
          sq += sxf<1>(sq); sq += sxf<2>(sq); sq += sxf<4>(sq); sq += sxf<8>(sq);
          if (ch == 0) part[(size_t)(b * SEQ + q0 + wid * 32 + row) * 128 + h] = sq; } }
    __syncthreads();
#undef ATT_SLOAD
#undef ATT_SWRITE
}
}

__device__ __forceinline__ void late_weight_conversion(const Args& a, unsigned char* ws, LAS unsigned char* lds, int gw, int NGW, int wave, int lane) {
    LAS unsigned* scr = (LAS unsigned*)(lds + wave * 16384);
    constexpr int I_OUT = (DM / 64) * (DM / 64), I_G = (DM / 64) * (DFF / 64), I_DN = (DK2 / 64) * (DM / 64), I_DN8 = (DK1 / 64) * (DM / 64);
    constexpr int NITEMS = I_OUT + 2 * I_G;
#define TR_DECODE(T, IT) do { int r = (IT); \
        if (r < I_OUT) { T = tr_make(a.w_out, DM, DM, (bf16*)(ws + WS_WOUT), 0, nullptr, r); { const int k0_ = 64 * (r / (DM / 64)); T.gain = k0_ < DA ? a.g_attn_out + k0_ : a.g_rnn_out + (k0_ - DA); } break; } r -= I_OUT; \
        if (r < I_G) { T = tr_make(a.w_ffn_gate, DM, DFF, (bf16*)(ws + WS_WGU), 1, a.g_ffn, r); break; } r -= I_G; \
        { T = tr_make(a.w_ffn_up, DM, DFF, (bf16*)(ws + WS_WGU), 2, a.g_ffn, r); } } while (0)
    if (gw < NITEMS) {
        TrItem ta, tb; f32x4 va[16], vb[16];
        TR_DECODE(ta, gw); tr_load(ta, va, lane);
        for (int it = gw;;) {
            { const int itn = it + NGW; const bool has = itn < NITEMS; const int itc = has ? itn : it; TR_DECODE(tb, itc); tr_load(tb, vb, lane);
              tr_process(ta, va, scr, lane); if (!has) break; it = itn; }
            { const int itn = it + NGW; const bool has = itn < NITEMS; const int itc = has ? itn : it; TR_DECODE(ta, itc); tr_load(ta, va, lane);
              tr_process(tb, vb, scr, lane); if (!has) break; it = itn; }
        }
    }
#undef TR_DECODE
}

__device__ __forceinline__ void ple_side_work(const Args& a, unsigned char* ws, bf16* PE, LAS unsigned char* lds, int ww, int nw, int wave, int lane) {
    LAS unsigned* scr = (LAS unsigned*)(lds + wave * 16384);
    constexpr int I_PG = (DM / 64) * (DM / 64);
    { constexpr int I_DN8 = (DK1 / 64) * (DM / 64);
      for (int it = ww; it < I_DN8; it += nw) { const int kb = it >> 6, nb = it & 63; TrItem t; t.src = a.w_ffn_down + (size_t)(64 * kb) * DM + 64 * nb; t.N = DM; t.K = DPITCH; t.keep = 0; t.scale = 1.0f; t.gain = nullptr;
          t.dst = (bf16*)(ws + WS_WDN + (size_t)(64 * nb) * DPITCH + 64 * kb); f32x4 v8[16]; tr8_load(t, v8, lane); tr8_process(t, v8, WDN_SCALE, scr, lane); } }
    { constexpr int I_DN = (DK2 / 64) * (DM / 64);
#define DN_DECODE(T, IT) do { T = tr_make(a.w_ffn_down + (size_t)DK1 * DM, DPITCH / 2, DM, (bf16*)(ws + WS_WDN + DK1), 0, nullptr, (IT)); T.scale = WDN_SCALE; } while (0)
      if (ww < I_DN) { TrItem ta, tb; f32x4 va[16], vb[16];
          DN_DECODE(ta, ww); tr_load(ta, va, lane);
          for (int it = ww;;) {
              { const int itn = it + nw; const bool has = itn < I_DN; const int itc = has ? itn : it; DN_DECODE(tb, itc); tr_load(tb, vb, lane);
                tr_process(ta, va, scr, lane); if (!has) break; it = itn; }
              { const int itn = it + nw; const bool has = itn < I_DN; const int itc = has ? itn : it; DN_DECODE(ta, itc); tr_load(ta, va, lane);
                tr_process(tb, vb, scr, lane); if (!has) break; it = itn; }
          } }
#undef DN_DECODE
    }
    for (int it = ww; it < I_PG; it += nw) { const int kb = it >> 6, nb = it & 63; TrItem t; t.src = a.w_ple_gate + (size_t)(64 * kb) * DM + 64 * nb; t.N = DM; t.K = DM; t.keep = 0; t.scale = 1.0f; t.gain = a.g_ple + 64 * kb;
        t.dst = (bf16*)(ws + WS_WPG + (size_t)(64 * nb) * DM + 64 * kb); f32x4 v8[16]; tr8_load(t, v8, lane); tr8_process(t, v8, 128.0f, scr, lane); }
}

constexpr int CW_BAR = 4096;
constexpr size_t CTL_ZERO_BYTES = 384 * 1024;
constexpr int MISC_OFF = 131072;

__global__ void __launch_bounds__(NWAVES * 64, 2) mega_fwd(Args a) {
    extern __shared__ __attribute__((aligned(16))) unsigned char lds_raw[];
    LAS unsigned char* lds = (LAS unsigned char*)lds_raw;
    const int tid = threadIdx.x, lane = tid & 63, wave = __builtin_amdgcn_readfirstlane(tid >> 6);
    const int G = gridDim.x, gw = blockIdx.x * NWAVES + wave, NGW = G * NWAVES;
    unsigned char* ws = a.ws; float* out = a.out;
    bf16 *A1 = (bf16*)(ws + WS_A1), *A2 = (bf16*)(ws + WS_A2), *PE = (bf16*)(ws + WS_PE), *PB = (bf16*)(ws + WS_PB), *HB = (bf16*)(ws + WS_HB), *HID = (bf16*)(ws + WS_HID), *XB = (bf16*)out;
    unsigned long long *SS1 = (unsigned long long*)(ws + WS_SS1), *SS2 = (unsigned long long*)(ws + WS_SS2);
    for (int u = tid; u < (LDS_BYTES - MISC_OFF) / 4; u += NWAVES * 64) ((LAS unsigned*)(lds + MISC_OFF))[u] = 0u;
    __syncthreads();
    XcdBarrier bar = xcd_barrier_post((unsigned*)(ws + WS_CTL) + CW_BAR, (volatile LAS unsigned*)(lds + MISC_OFF));
#define GRID_BAR() xcd_barrier(bar)

    {
        LAS unsigned* scr = (LAS unsigned*)(lds + wave * 16384);
        constexpr int I_IN = (DM / 64) * (DIN / 64), I_PP = (PLE / 64) * (DM / 64), I_RG = 16 * 4;
        constexpr int NITEMS = I_IN + I_PP + 2 * I_RG;
#define TR_DECODE(T, IT) do { int r = (IT); \
            if (r < I_IN) { T = tr_make(a.w_in, DM, DIN, (bf16*)(ws + WS_WIN), 0, a.g_mix, r); break; } r -= I_IN; \
            if (r < I_PP) { T = tr_make(a.w_ple_proj, PLE, DM, (bf16*)(ws + WS_WPP), 0, nullptr, r); break; } r -= I_PP; \
            if (r < I_RG) { const int blk = r / 4; T = tr_make(a.w_rg_a + (size_t)blk * 16384, 128, 128, (bf16*)(ws + WS_WRA) + (size_t)blk * 16384, 0, nullptr, r % 4); break; } r -= I_RG; \
            { const int blk = r / 4; T = tr_make(a.w_rg_x + (size_t)blk * 16384, 128, 128, (bf16*)(ws + WS_WRX) + (size_t)blk * 16384, 0, nullptr, r % 4); } } while (0)
        if (gw < NITEMS) {
            TrItem ta, tb; f32x4 va[16], vb[16];
            TR_DECODE(ta, gw); ta.keep = 1; tr_load(ta, va, lane);
            for (int it = gw;;) {
                { const int itn = it + NGW; const bool has = itn < NITEMS; const int itc = has ? itn : it; TR_DECODE(tb, itc); tb.keep = 1; tr_load(tb, vb, lane);
                  tr_process(ta, va, scr, lane); if (!has) break; it = itn; }
                { const int itn = it + NGW; const bool has = itn < NITEMS; const int itc = has ? itn : it; TR_DECODE(ta, itc); ta.keep = 1; tr_load(ta, va, lane);
                  tr_process(tb, vb, scr, lane); if (!has) break; it = itn; }
            }
        }
#undef TR_DECODE
        cast_rows(a.x, XB, (signed char*)out + (size_t)128 * MiB, (float*)(ws + WS_RSX), gw, NGW, lane);
        { const f32x4* src = (const f32x4*)a.p; v2u* dst = (v2u*)PB; const size_t n4 = (size_t)M * PLE / 4;
          for (size_t i = (size_t)blockIdx.x * 512 + tid; i < n4; i += (size_t)G * 512) { const f32x4 v = src[i]; v2u w; w.x = pk2(v.x, v.y); w.y = pk2(v.z, v.w); dst[i] = w; } }
    }
    GRID_BAR();
    { int lane1; asm volatile("v_mbcnt_lo_u32_b32 %0, -1, 0\n\tv_mbcnt_hi_u32_b32 %0, -1, %0" : "=v"(lane1));
      quant_rows_i8((const bf16*)(ws + WS_WIN), (signed char*)out + (size_t)192 * MiB, (float*)(ws + WS_SBIN), NI8, gw, NGW, lane1); }
    {
        pg8::Gemm g{XB, (const bf16*)(ws + WS_WIN) + (size_t)NI8 * DM, M, DIN - NI8, DM, 0}; pg8::StaticOrder S; S.init(M, DIN - NI8, G, (int)blockIdx.x);
        pg8::EpiBf16S E{A2 + NI8, (const float*)(ws + WS_RSX), DIN, 0, 1.0f, 0};
        pg8::gemm_phase<pg8::EpiBf16S, pg8::StaticOrder, true, true>(lds, g, S, E);
    }
    {
        pg8::Gemm g{PB, (const bf16*)(ws + WS_WPP), M, DM, PLE, 0}; pg8::StaticOrder S; S.init(M, DM, G, (int)blockIdx.x);
        pg8::EpiPe E{PE, a.g_ple_out, (float*)(ws + WS_HB8), DM, 0};
        pg8::gemm_phase<pg8::EpiPe, pg8::StaticOrder, true, true>(lds, g, S, E);
    }
    GRID_BAR();
    { int lane1b; asm volatile("v_mbcnt_lo_u32_b32 %0, -1, 0\n\tv_mbcnt_hi_u32_b32 %0, -1, %0" : "=v"(lane1b));
      const float* part = (const float*)(ws + WS_HB8); float* rspe = (float*)(ws + WS_SS1);
      for (int m = gw; m < M; m += NGW) { const float v = wave_sum(part[(size_t)m * 64 + lane1b]); if (lane1b == 0) rspe[m] = __builtin_amdgcn_rsqf(v * (1.0f / 4096.0f) + NORM_EPS); } }
    {
        pg8::Gemm g{(const bf16*)((const signed char*)out + (size_t)128 * MiB), (const bf16*)((const signed char*)out + (size_t)192 * MiB), M, NI8, DM, 0}; pg8::StaticOrder S; S.init(M, NI8, G, (int)blockIdx.x);
        pg8::EpiBf16Si8 E{A2, (const float*)(ws + WS_RSXQ), (const float*)(ws + WS_SBIN), DIN, DA / 256, QSCALE, 0};
        pg8::gemm_phase_i8<pg8::EpiBf16Si8, pg8::StaticOrder>(lds, g, S, E);
    }
    GRID_BAR();
    const bool conv_first = ((blockIdx.x >> 3) & 1) != 0;
    if (conv_first) late_weight_conversion(a, ws, lds, gw, NGW, wave, lane);
    __syncthreads();
    for (int u = blockIdx.x; u < NB * 16 * 4; u += G) rg::rglru_unit(a, A2, A1, (float*)(ws + WS_HB8), (const bf16*)(ws + WS_WRA), (const bf16*)(ws + WS_WRX), lds, u);
    for (int u = blockIdx.x; u < NB * NH * (SEQ / 256); u += G) att::attn_unit(A2, A1, (float*)(ws + WS_HB8), lds, u);
    __syncthreads();
    if (!conv_first) late_weight_conversion(a, ws, lds, gw, NGW, wave, lane);
    GRID_BAR();
    { int lane5; asm volatile("v_mbcnt_lo_u32_b32 %0, -1, 0\n\tv_mbcnt_hi_u32_b32 %0, -1, %0" : "=v"(lane5));
      { const float* part = (const float*)(ws + WS_HB8); float* rat = (float*)(ws + WS_RSX); float* rsr = (float*)(ws + WS_RSXQ);
        for (int m = gw; m < M; m += NGW) { const float sa = wave_sum(lane5 < 16 ? part[(size_t)m * 128 + lane5] : 0.f), sr = wave_sum(part[(size_t)m * 128 + 64 + lane5]);
            const float ra = __builtin_amdgcn_rsqf(sa * (1.0f / 2048.0f) + NORM_EPS), rr = __builtin_amdgcn_rsqf(sr * (1.0f / 2048.0f) + NORM_EPS);
            if (lane5 == 0) { rat[m] = ra / rr; rsr[m] = rr; } } }
      quant_rows_i8((const bf16*)(ws + WS_WGU), (signed char*)out + (size_t)128 * MiB, (float*)(ws + WS_SB), NGU, gw, NGW, lane5); }
    GRID_BAR();
    { unsigned char* w_ = a.ws; float* o_ = a.out; asm volatile("" : "+s"(w_), "+s"(o_));
    {
        pg8::Gemm g{((bf16*)(w_ + WS_A1)), (const bf16*)(w_ + WS_WOUT), M, DM, DM, 0}; pg8::StaticOrder S; S.init(M, DM, G, (int)blockIdx.x);
        pg8::EpiResMid E{{nullptr, ((bf16*)(w_ + WS_HB)), nullptr, nullptr, ((bf16*)o_), DM, 1.0f}, (const float*)(w_ + WS_RSX), (const float*)(w_ + WS_RSXQ)};
        pg8::gemm_phase<pg8::EpiResMid, pg8::StaticOrder, true, true>(lds, g, S, E);
    }
    GRID_BAR();
    }
    { unsigned char* w_ = a.ws; float* o_ = a.out; asm volatile("" : "+s"(w_), "+s"(o_));
    { int lane7; asm volatile("v_mbcnt_lo_u32_b32 %0, -1, 0\n\tv_mbcnt_hi_u32_b32 %0, -1, %0" : "=v"(lane7));
      quant_rows_i8<true>(((bf16*)(w_ + WS_HB)), (signed char*)o_, (float*)(w_ + WS_SA), M, gw, NGW, lane7); }
    GRID_BAR();
    }
    { unsigned char* w_ = a.ws; float* o_ = a.out; asm volatile("" : "+s"(w_), "+s"(o_));
    {
        pg8::Gemm g{(const bf16*)o_, (const bf16*)((const signed char*)o_ + (size_t)128 * MiB), M, NGU, DM, 0}; pg8::StaticOrder S; S.init(M, NGU, G, (int)blockIdx.x);
        pg8::EpiSwiGLUi8 E{(unsigned char*)((bf16*)(w_ + WS_HID)), (const float*)(w_ + WS_SA), (const float*)(w_ + WS_SB), DPITCH, DK1};
        pg8::gemm_phase_i8<pg8::EpiSwiGLUi8, pg8::StaticOrder>(lds, g, S, E);
        const int rounds = (S.nwg + G - 1) / G, full_last = S.nwg - (rounds - 1) * G, nshort = G - full_last, c = (int)blockIdx.x;
        int lane8; asm volatile("v_mbcnt_lo_u32_b32 %0, -1, 0\n\tv_mbcnt_hi_u32_b32 %0, -1, %0" : "=v"(lane8));
        if (nshort == 0) ple_side_work(a, w_, ((bf16*)(w_ + WS_PE)), lds, c * NWAVES + wave, G * NWAVES, wave, lane8);
        else if (c >= full_last) ple_side_work(a, w_, ((bf16*)(w_ + WS_PE)), lds, (c - full_last) * NWAVES + wave, nshort * NWAVES, wave, lane8);
    }
    GRID_BAR();
    }
    { unsigned char* w_ = a.ws; float* o_ = a.out; asm volatile("" : "+s"(w_), "+s"(o_));
    {
        pg8::Gemm g{((bf16*)(w_ + WS_HID)), (const bf16*)(w_ + WS_WDN), M, DM, DPITCH, 0}; pg8::StaticOrder S; S.init(M, DM, G, (int)blockIdx.x, 2);
        pg8::EpiRes<true, false> E{nullptr, ((bf16*)(w_ + WS_HB)), ((unsigned long long*)(w_ + WS_SS2)), w_ + WS_HB8, nullptr, DM, 1.0f / (HID_SCALE * WDN_SCALE)};
        pg8::gemm_phase_fp8<pg8::EpiRes<true, false>, pg8::StaticOrder, DN8>(lds, g, S, E);
    }
    GRID_BAR();
    }
    { unsigned char* w_ = a.ws; float* o_ = a.out; asm volatile("" : "+s"(w_), "+s"(o_));
    {
        pg8::Gemm g{(const bf16*)(w_ + WS_HB8), (const bf16*)(w_ + WS_WPG), M, DM, DM, 0}; pg8::StaticOrder S; S.init(M, DM, G, (int)blockIdx.x);
        pg8::EpiPleGate E{((bf16*)(w_ + WS_HB)), ((bf16*)(w_ + WS_A1)), ((bf16*)(w_ + WS_PE)), ((unsigned long long*)(w_ + WS_SS2)), (const float*)(w_ + WS_SS1), DM, 0};
        pg8::gemm_phase_fp8<pg8::EpiPleGate, pg8::StaticOrder>(lds, g, S, E);
    }
    GRID_BAR();
    }
    { unsigned char* w_ = a.ws; float* o_ = a.out; asm volatile("" : "+s"(w_), "+s"(o_));
    { int lane12; asm volatile("v_mbcnt_lo_u32_b32 %0, -1, 0\n\tv_mbcnt_hi_u32_b32 %0, -1, %0" : "=v"(lane12));
      rms_rows_b2f(((bf16*)(w_ + WS_A1)), a.g_final, o_, gw, NGW, lane12); }
    }
}

extern "C" void kernel_launch(void* const* d_in, const int* in_sizes, int n_in, void* d_out, int out_size, void* d_ws, size_t ws_size, hipStream_t stream) {
    static int grid = 0;
    if (grid == 0) {
        if (n_in != 23 || in_sizes[0] != M * DM || out_size != M * DM || ws_size < WS_END) { fprintf(stderr, "kernel_launch: unexpected shapes: n_in %d in0 %d out %d ws %zu (need %zu)\n", n_in, n_in > 0 ? in_sizes[0] : -1, out_size, ws_size, (size_t)WS_END); grid = -1; return; }
        int dev = 0, cus = 0, per_cu = 0;
        if (hipGetDevice(&dev) != hipSuccess || hipDeviceGetAttribute(&cus, hipDeviceAttributeMultiprocessorCount, dev) != hipSuccess) { grid = -1; return; }
        if (hipFuncSetAttribute((const void*)mega_fwd, hipFuncAttributeMaxDynamicSharedMemorySize, LDS_BYTES) != hipSuccess) { fprintf(stderr, "kernel_launch: hipFuncSetAttribute failed\n"); grid = -1; return; }
        if (hipOccupancyMaxActiveBlocksPerMultiprocessor(&per_cu, (const void*)mega_fwd, NWAVES * 64, LDS_BYTES) != hipSuccess || per_cu < 1) { fprintf(stderr, "kernel_launch: occupancy query says %d blocks per CU\n", per_cu); (void)hipGetLastError(); }
        grid = cus;
    }
    if (grid < 0) return;
    if (hipMemsetAsync((char*)d_ws + WS_CTL, 0, CTL_ZERO_BYTES, stream) != hipSuccess) return;
    Args a{};
    const float** ap = (const float**)&a;
    for (int i = 0; i < 23; ++i) ap[i] = (const float*)d_in[i];
    a.out = (float*)d_out; a.ws = (unsigned char*)d_ws;
    hipLaunchKernelGGL(mega_fwd, dim3(grid), dim3(NWAVES * 64), LDS_BYTES, stream, a);
}
```
